# Optimizing an MI355X kernel written in HIP

```python
import math
import jax, jax.numpy as jnp
from jax import lax
import numpy as np

D_MODEL = 1024
BATCH = 8
SEQ = 4096
DEPTH = 2

GRID_W = 64
CTX_LEN = 256
EPS = 1e-6
A_HEADS = 6
A_QK_DIM = 32
A_V_DIM = 2 * A_QK_DIM
ROPE_THETA = 10000.0
Q_BLOCK = 128
S5_GROUPS = 16
S5_GROUP_CH = 16
S5_STATE = 64
N_HEADS = 6
N_HEAD_DIM = 64
WIN_ROWS = 8
WIN_COLS = 16
A_QK_WIDTH = A_HEADS * 2 * A_QK_DIM
A_WIDTH = A_HEADS * A_V_DIM
B_WIDTH = S5_GROUPS * S5_GROUP_CH
C_WIDTH = N_HEADS * N_HEAD_DIM
MIX_WIDTH = A_WIDTH + B_WIDTH + C_WIDTH
Q_COLS = A_QK_WIDTH + C_WIDTH
KV_COLS = A_QK_WIDTH + A_WIDTH + 2 * C_WIDTH + B_WIDTH
IN_COLS = Q_COLS + KV_COLS
N_EXPERTS = 64
TOP_K = 8
N_GROUPS = 8
TOPK_GROUPS = 4
EXPERT_DIM = 256
SHARED_DIM = 256
ROUTED_SCALE = 2.5

kernel_name = "hymba_style_diffusion_hybrid_moe"

F32 = jnp.float32


def rms_norm(x, g):
    xf = x.astype(F32)
    y = xf * lax.rsqrt(jnp.mean(xf * xf, axis=-1, keepdims=True) + EPS)
    return (y * g.astype(F32)).astype(x.dtype)


def rope_2d(x, rows, cols):
    half = A_QK_DIM // 2
    nf = half // 2
    inv = ROPE_THETA ** (-jnp.arange(nf, dtype=F32) / nf)

    def rot(xa, pos):
        ang = pos[:, None] * inv
        cos = jnp.cos(ang)[:, None, None, :]
        sin = jnp.sin(ang)[:, None, None, :]
        x1, x2 = xa[..., :nf], xa[..., nf:]
        return jnp.concatenate([x1 * cos - x2 * sin, x1 * sin + x2 * cos], axis=-1)

    xf = x.astype(F32)
    return jnp.concatenate([rot(xf[..., :half], rows), rot(xf[..., half:], cols)], axis=-1).astype(x.dtype)


def split_q(p):
    b, t = p.shape[:2]
    qa = p[..., :A_QK_WIDTH].reshape(b, t, A_HEADS, 2, A_QK_DIM)
    qn = p[..., A_QK_WIDTH:].reshape(b, t, N_HEADS, N_HEAD_DIM)
    return qa, qn


def split_kv(p):
    b, t = p.shape[:2]
    o1 = A_QK_WIDTH
    o2 = o1 + A_WIDTH
    o3 = o2 + C_WIDTH
    o4 = o3 + C_WIDTH
    ka = p[..., :o1].reshape(b, t, A_HEADS, 2, A_QK_DIM)
    va = p[..., o1:o2].reshape(b, t, A_HEADS, A_V_DIM)
    kn = p[..., o2:o3].reshape(b, t, N_HEADS, N_HEAD_DIM)
    vn = p[..., o3:o4].reshape(b, t, N_HEADS, N_HEAD_DIM)
    u = p[..., o4:]
    return ka, va, kn, vn, u


def diff_attend(q, k, v, lam):
    s = jnp.einsum('bqhsd,bkhsd->bhsqk', q, k).astype(F32) * (A_QK_DIM ** -0.5)
    p = jax.nn.softmax(s, axis=-1)
    pd = p[:, :, 0] - lam * p[:, :, 1]
    return jnp.einsum('bhqk,bkhd->bqhd', pd.astype(v.dtype), v)


def diff_attn_mixer(q, k, v, k_ctx, v_ctx, q_ctx, g_q, g_k, lam_vec, g_sub, lam_init):
    b, L = q.shape[:2]
    pos = jnp.arange(L)
    rows = (pos // GRID_W).astype(F32)
    cols = (pos % GRID_W).astype(F32)
    q = rope_2d(rms_norm(q, g_q), rows, cols)
    k = rope_2d(rms_norm(k, g_k), rows, cols)
    k_ctx = rms_norm(k_ctx, g_k)
    lv = lam_vec.astype(F32)
    lam = jnp.exp(jnp.sum(lv[0] * lv[1])) - jnp.exp(jnp.sum(lv[2] * lv[3])) + lam_init
    k_all = jnp.concatenate([k, k_ctx], axis=1)
    v_all = jnp.concatenate([v, v_ctx], axis=1)
    nb = L // Q_BLOCK
    qb = jnp.moveaxis(q.reshape(b, nb, Q_BLOCK, A_HEADS, 2, A_QK_DIM), 1, 0)
    o = lax.map(lambda qq: diff_attend(qq, k_all, v_all, lam), qb)
    o = jnp.moveaxis(o, 0, 1).reshape(b, L, A_HEADS, A_V_DIM)

    def finish(t):
        return (rms_norm(t, g_sub) * (1.0 - lam_init)).reshape(t.shape[0], t.shape[1], A_WIDTH)

    out = finish(o)
    out_ctx = None
    if q_ctx is not None:
        out_ctx = finish(diff_attend(rms_norm(q_ctx, g_q), k_ctx, v_ctx, lam))
    return out, out_ctx


def _lin_combine(left, right):
    a1, b1 = left
    a2, b2 = right
    return a1 * a2, a2 * b1 + b2


def s5_mixer(u, u_ctx, a_re, a_im, log_dt, b_re, b_im, c_re, c_im, d_skip, w_glu, b_glu, need_ctx_out):
    lam = lax.complex(a_re.astype(F32), a_im.astype(F32))
    dt = jnp.exp(log_dt.astype(F32))[..., None]
    a_bar = jnp.exp(lam * dt)
    b_bar = ((a_bar - 1.0) / lam)[..., None] * lax.complex(b_re.astype(F32), b_im.astype(F32))
    c_mat = lax.complex(c_re.astype(F32), c_im.astype(F32))

    def drive(v):
        bv, t = v.shape[:2]
        vg = v.astype(F32).reshape(bv, t, S5_GROUPS, S5_GROUP_CH).astype(jnp.complex64)
        return jnp.einsum('btgp,kgnp->kbtgn', vg, b_bar)

    def scan(a, bu, reverse):
        _, s = lax.associative_scan(_lin_combine, (jnp.broadcast_to(a, bu.shape), bu), reverse=reverse, axis=1)
        return s

    def readout(s_f, s_b, v):
        bv, t = v.shape[:2]
        y = jnp.real(jnp.einsum('btgn,gpn->btgp', s_f, c_mat[0]) + jnp.einsum('btgn,gpn->btgp', s_b, c_mat[1]))
        y = y.reshape(bv, t, B_WIDTH) + d_skip.astype(F32) * v.astype(F32)
        g = jax.nn.gelu(y)
        return (g * jax.nn.sigmoid(g @ w_glu.astype(F32) + b_glu.astype(F32))).astype(v.dtype)

    bu_c = drive(u_ctx)
    s_cf = scan(a_bar[0], bu_c[0], False)
    s_cb = scan(a_bar[1], bu_c[1], True)
    bu = drive(u)
    bu_f = bu[0].at[:, 0].add(a_bar[0] * s_cf[:, -1])
    bu_b = bu[1].at[:, -1].add(a_bar[1] * s_cb[:, 0])
    out = readout(scan(a_bar[0], bu_f, False), scan(a_bar[1], bu_b, True), u)
    out_ctx = readout(s_cf, s_cb, u_ctx) if need_ctx_out else None
    return out, out_ctx


def na_mixer(q, k, v, k_ctx, v_ctx, q_ctx, g_q, g_k, rpb):
    b, L = q.shape[:2]
    R = L // GRID_W
    wr = min(WIN_ROWS, R)
    scale = N_HEAD_DIM ** -0.5
    q = rms_norm(q, g_q)
    k = rms_norm(k, g_k)
    k_ctx = rms_norm(k_ctx, g_k)

    def grid(t):
        return t.reshape(b, R, GRID_W, N_HEADS, N_HEAD_DIM).transpose(0, 3, 1, 2, 4)

    qg, kg, vg = grid(q), grid(k), grid(v)
    r_ids = jnp.arange(R)
    row_idx = jnp.clip(r_ids - wr // 2, 0, R - wr)[:, None] + jnp.arange(wr)[None, :]
    k_rows = kg[:, :, row_idx]
    v_rows = vg[:, :, row_idx]
    c_ids = jnp.arange(GRID_W)
    col_start = jnp.clip(c_ids - WIN_COLS // 2, 0, GRID_W - WIN_COLS)
    col_mask = (c_ids[None, :] >= col_start[:, None]) & (c_ids[None, :] < col_start[:, None] + WIN_COLS)
    dr = row_idx - r_ids[:, None] + (WIN_ROWS - 1)
    dc = jnp.clip(c_ids[None, :] - c_ids[:, None], -(WIN_COLS - 1), WIN_COLS - 1) + (WIN_COLS - 1)
    bias = rpb.astype(F32)[:, dr[:, None, :, None], dc[None, :, None, :]]
    s_loc = jnp.einsum('bhrqd,bhrjkd->bhrqjk', qg, k_rows).astype(F32) * scale + bias[None]
    s_loc = jnp.where(col_mask[:, None, :], s_loc, -jnp.inf)
    s_ctx = jnp.einsum('bhrqd,bchd->bhrqc', qg, k_ctx).astype(F32) * scale
    n_loc = wr * GRID_W
    p = jax.nn.softmax(jnp.concatenate([s_loc.reshape(b, N_HEADS, R, GRID_W, n_loc), s_ctx], axis=-1), axis=-1)
    p = p.astype(v.dtype)
    p_loc = p[..., :n_loc].reshape(b, N_HEADS, R, GRID_W, wr, GRID_W)
    o = jnp.einsum('bhrqjk,bhrjkd->bhrqd', p_loc, v_rows) + jnp.einsum('bhrqc,bchd->bhrqd', p[..., n_loc:], v_ctx)
    out = o.transpose(0, 2, 3, 1, 4).reshape(b, L, C_WIDTH)
    out_ctx = None
    if q_ctx is not None:
        sc = jnp.einsum('bqhd,bkhd->bhqk', rms_norm(q_ctx, g_q), k_ctx).astype(F32) * scale
        pc = jax.nn.softmax(sc, axis=-1).astype(v_ctx.dtype)
        out_ctx = jnp.einsum('bhqk,bkhd->bqhd', pc, v_ctx).reshape(q_ctx.shape[0], q_ctx.shape[1], C_WIDTH)
    return out, out_ctx


def moe_ffn(h, w_router, e_bias, w_gate, w_up, w_down, ws_gate, ws_up, ws_down):
    t = h.shape[0]
    scores = jax.nn.sigmoid(h.astype(F32) @ w_router.astype(F32))
    biased = scores + e_bias.astype(F32)
    grp = biased.reshape(t, N_GROUPS, N_EXPERTS // N_GROUPS)
    grp_score = lax.top_k(grp, 2)[0].sum(-1)
    _, g_idx = lax.top_k(grp_score, TOPK_GROUPS)
    g_mask = jax.nn.one_hot(g_idx, N_GROUPS, dtype=F32).sum(1) > 0
    e_mask = jnp.repeat(g_mask, N_EXPERTS // N_GROUPS, axis=-1)
    _, e_idx = lax.top_k(jnp.where(e_mask, biased, -jnp.inf), TOP_K)
    w = jnp.take_along_axis(scores, e_idx, axis=-1)
    w = w / jnp.sum(w, axis=-1, keepdims=True) * ROUTED_SCALE
    gates = jnp.einsum('tke,tk->et', jax.nn.one_hot(e_idx, N_EXPERTS, dtype=F32), w).astype(h.dtype)

    def expert(acc, p):
        wg, wu, wd, g = p
        return acc + ((jax.nn.silu(h @ wg) * (h @ wu)) @ wd) * g[:, None], None

    routed, _ = lax.scan(expert, jnp.zeros_like(h), (w_gate, w_up, w_down, gates))
    shared = (jax.nn.silu(h @ ws_gate) * (h @ ws_up)) @ ws_down
    return routed + shared


def setup_inputs(seed: int = 0) -> dict:
    key = jax.random.key(seed)
    ks = iter(jax.random.split(key, 40))
    D = D_MODEL
    Ld = DEPTH
    G, N, P = S5_GROUPS, S5_STATE, S5_GROUP_CH

    def nrm(shape, s):
        return jax.random.normal(next(ks), shape, F32) * s

    n_idx = jnp.arange(N, dtype=F32)
    return {
        "x": nrm((BATCH, SEQ, D), 1.0),
        "c": nrm((BATCH, D), 1.0),
        "ctx": nrm((BATCH, CTX_LEN, D), 1.0),
        "c_ctx": nrm((D,), 1.0),
        "w_mod": nrm((Ld, D, 6 * D), 0.5 * D ** -0.5),
        "b_mod": nrm((Ld, 6 * D), 0.01),
        "g_mix": 1.0 + nrm((Ld, D), 0.01),
        "g_ffn": 1.0 + nrm((Ld, D), 0.01),
        "w_in": nrm((Ld, D, IN_COLS), D ** -0.5),
        "w_out": nrm((Ld, MIX_WIDTH, D), MIX_WIDTH ** -0.5),
        "a_gq": 1.0 + nrm((Ld, A_QK_DIM), 0.01),
        "a_gk": 1.0 + nrm((Ld, A_QK_DIM), 0.01),
        "a_lambda": nrm((Ld, 4, A_QK_DIM), 0.1),
        "a_gsub": 1.0 + nrm((Ld, A_V_DIM), 0.01),
        "n_gq": 1.0 + nrm((Ld, N_HEAD_DIM), 0.01),
        "n_gk": 1.0 + nrm((Ld, N_HEAD_DIM), 0.01),
        "n_rpb": nrm((Ld, N_HEADS, 2 * WIN_ROWS - 1, 2 * WIN_COLS - 1), 0.1),
        "s5_a_re": -0.5 + nrm((Ld, 2, G, N), 0.01),
        "s5_a_im": jnp.pi * n_idx + nrm((Ld, 2, G, N), 0.01),
        "s5_log_dt": jax.random.uniform(next(ks), (Ld, 2, G), F32, math.log(1e-3), math.log(1e-1)),
        "s5_b_re": nrm((Ld, 2, G, N, P), (2 * P) ** -0.5),
        "s5_b_im": nrm((Ld, 2, G, N, P), (2 * P) ** -0.5),
        "s5_c_re": nrm((Ld, 2, G, P, N), (2 * N) ** -0.5),
        "s5_c_im": nrm((Ld, 2, G, P, N), (2 * N) ** -0.5),
        "s5_d": nrm((Ld, B_WIDTH), 1.0),
        "s5_w_glu": nrm((Ld, B_WIDTH, B_WIDTH), B_WIDTH ** -0.5),
        "s5_b_glu": nrm((Ld, B_WIDTH), 0.01),
        "w_router": nrm((Ld, D, N_EXPERTS), D ** -0.5),
        "e_bias": nrm((Ld, N_EXPERTS), 0.01),
        "w_gate": nrm((Ld, N_EXPERTS, D, EXPERT_DIM), D ** -0.5),
        "w_up": nrm((Ld, N_EXPERTS, D, EXPERT_DIM), D ** -0.5),
        "w_down": nrm((Ld, N_EXPERTS, EXPERT_DIM, D), EXPERT_DIM ** -0.5),
        "ws_gate": nrm((Ld, D, SHARED_DIM), D ** -0.5),
        "ws_up": nrm((Ld, D, SHARED_DIM), D ** -0.5),
        "ws_down": nrm((Ld, SHARED_DIM, D), SHARED_DIM ** -0.5),
    }


def reference(x, c, ctx, c_ctx, w_mod, b_mod, g_mix, g_ffn, w_in, w_out, a_gq, a_gk, a_lambda, a_gsub,
              n_gq, n_gk, n_rpb, s5_a_re, s5_a_im, s5_log_dt, s5_b_re, s5_b_im, s5_c_re, s5_c_im, s5_d,
              s5_w_glu, s5_b_glu, w_router, e_bias, w_gate, w_up, w_down, ws_gate, ws_up, ws_down):
    b, L, D = x.shape
    lc = ctx.shape[1]
    ctx_s = ctx
    cond = jax.nn.silu(c.astype(F32))
    cond_ctx = jax.nn.silu(c_ctx.astype(F32))
    for l in range(DEPTH):
        last = l == DEPTH - 1
        lam_init = 0.8 - 0.6 * math.exp(-0.3 * l)
        mod = (cond @ w_mod[l].astype(F32) + b_mod[l].astype(F32)).astype(x.dtype)
        sh1, sc1, gt1, sh2, sc2, gt2 = jnp.split(mod[:, None, :], 6, axis=-1)
        n_cm = 2 if last else 6
        mod_c = (cond_ctx @ w_mod[l][:, :n_cm * D].astype(F32) + b_mod[l][:n_cm * D].astype(F32)).astype(x.dtype)
        cm = jnp.split(mod_c, n_cm)

        h = rms_norm(x, g_mix[l]) * (1.0 + sc1) + sh1
        hc = rms_norm(ctx_s, g_mix[l]) * (1.0 + cm[1]) + cm[0]
        qa, qn = split_q(h @ w_in[l][:, :Q_COLS])
        ka, va, kn, vn, u = split_kv(h @ w_in[l][:, Q_COLS:])
        ka_c, va_c, kn_c, vn_c, u_c = split_kv(hc @ w_in[l][:, Q_COLS:])
        if last:
            qa_c, qn_c = None, None
        else:
            qa_c, qn_c = split_q(hc @ w_in[l][:, :Q_COLS])
        oa, oa_c = diff_attn_mixer(qa, ka, va, ka_c, va_c, qa_c, a_gq[l], a_gk[l], a_lambda[l], a_gsub[l], lam_init)
        ob, ob_c = s5_mixer(u, u_c, s5_a_re[l], s5_a_im[l], s5_log_dt[l], s5_b_re[l], s5_b_im[l],
                            s5_c_re[l], s5_c_im[l], s5_d[l], s5_w_glu[l], s5_b_glu[l], not last)
        on, on_c = na_mixer(qn, kn, vn, kn_c, vn_c, qn_c, n_gq[l], n_gk[l], n_rpb[l])
        x = x + gt1 * (jnp.concatenate([oa, ob, on], axis=-1) @ w_out[l])
        if not last:
            ctx_s = ctx_s + cm[2] * (jnp.concatenate([oa_c, ob_c, on_c], axis=-1) @ w_out[l])

        h2 = (rms_norm(x, g_ffn[l]) * (1.0 + sc2) + sh2).reshape(b * L, D)
        if last:
            tokens = h2
        else:
            h2c = (rms_norm(ctx_s, g_ffn[l]) * (1.0 + cm[4]) + cm[3]).reshape(b * lc, D)
            tokens = jnp.concatenate([h2, h2c], axis=0)
        y = moe_ffn(tokens, w_router[l], e_bias[l], w_gate[l], w_up[l], w_down[l], ws_gate[l], ws_up[l], ws_down[l])
        x = x + gt2 * y[:b * L].reshape(b, L, D)
        if not last:
            ctx_s = ctx_s + cm[5] * y[b * L:].reshape(b, lc, D)
    return x
```

```cpp
#include <hip/hip_runtime.h>
#include <stdint.h>
#include <stdio.h>
#include <string.h>

#ifndef ONE_LAUNCH
#define ONE_LAUNCH 1
#endif
#ifndef REPEAT_PH
#define REPEAT_PH 0
#endif
#ifndef YK_FP8
#define YK_FP8 1
#endif
#ifndef NAIVE_GEMM
#define NAIVE_GEMM 0
#endif
#ifndef NAIVE_ATTN
#define NAIVE_ATTN 0
#endif
#ifndef NAIVE_S5
#define NAIVE_S5 0
#endif

#define DEV __device__ __forceinline__
typedef unsigned short u16;
typedef unsigned int u32;
using bf16x8 = __attribute__((ext_vector_type(8))) short;
using f32x4 = __attribute__((ext_vector_type(4))) float;
using f32x16 = __attribute__((ext_vector_type(16))) float;
using u32x4 = __attribute__((ext_vector_type(4))) unsigned;
#define LAS __attribute__((address_space(3)))

constexpr int D = 1024, NBATCH = 8, SEQ = 4096, LCTX = 256;
constexpr int TL = NBATCH * SEQ;
constexpr int TC = NBATCH * LCTX;
constexpr int TT = TL + TC;
constexpr int INC = 2560;
constexpr int NKEY = SEQ + LCTX;
constexpr int NEXP = 64;
constexpr int NTHREADS = 512;
constexpr int NBLK = 256;
constexpr int MAXROWS = TT * 8 + NEXP * 256;
constexpr int NPASS = 1;
constexpr int THALF = TT / NPASS;
constexpr float EPS = 1e-6f;
constexpr float LOG2E = 1.4426950408889634f;

constexpr size_t al(size_t x) { return (x + 255) & ~(size_t)255; }
constexpr size_t OFF_BAR = 0;
constexpr size_t OFF_MOD = OFF_BAR + 16384;
constexpr size_t OFF_ROPE = OFF_MOD + al(2 * 9 * 6144 * 4);
constexpr size_t OFF_MISC = OFF_ROPE + al(2 * 64 * 8 * 4);
constexpr size_t OFF_CNT = OFF_MISC + 4096;
constexpr size_t OFF_TILEE = OFF_CNT + al(256 * 64 * 4);
constexpr size_t OFF_ULIST = OFF_TILEE + al(1280 * 4);
constexpr size_t OFF_TOKE = OFF_ULIST + al(2 * 1536 * 4);
constexpr size_t OFF_TOKW = OFF_TOKE + al((size_t)TT * 8 * 4);
constexpr size_t OFF_LPOS = OFF_TOKW + al((size_t)TT * 8 * 4);
constexpr size_t OFF_ROWSLOT = OFF_LPOS + al((size_t)TT * 8 * 4);
constexpr size_t OFF_ROWGATE = OFF_ROWSLOT + al((size_t)MAXROWS * 4);
constexpr size_t OFF_KF = OFF_ROWGATE + al((size_t)MAXROWS * 4);
constexpr size_t OFF_WIN = OFF_KF + al((size_t)2 * 16 * 2 * 32 * 256 * 4);
constexpr size_t OFF_WOUT = OFF_WIN + al((size_t)2 * INC * D * 2);
constexpr size_t OFF_WGLU = OFF_WOUT + al((size_t)2 * D * D * 2);
constexpr size_t OFF_WSH1 = OFF_WGLU + al((size_t)2 * 256 * 256 * 2);
constexpr size_t OFF_WSH2 = OFF_WSH1 + al((size_t)2 * 512 * D * 2);
constexpr size_t OFF_CTXS = OFF_WSH2 + al((size_t)2 * D * 256 * 2);
constexpr size_t OFF_W2 = OFF_CTXS + al((size_t)TC * D * 4);
constexpr size_t OFF_W1 = OFF_W2 + al((size_t)NEXP * D * 256 * 2);
constexpr size_t OFF_HBUF = OFF_W1 + al((size_t)NEXP * 512 * D * 2);
constexpr size_t OFF_M1 = OFF_HBUF + al((size_t)TT * D * 2);
constexpr size_t OFF_M3 = OFF_M1 + al((size_t)16 * 256 * 512 * 2);
constexpr size_t OFF_R = OFF_M3 + al((size_t)16 * 512 * 768 * 2);
constexpr size_t OFF_QA = OFF_R;
constexpr size_t OFF_QAC = OFF_QA + al((size_t)NBATCH * 6 * 2 * SEQ * 32 * 2);
constexpr size_t OFF_KA = OFF_QAC + al((size_t)NBATCH * 6 * 2 * LCTX * 32 * 2);
constexpr size_t OFF_VAT = OFF_KA + al((size_t)NBATCH * 6 * NKEY * 64 * 2);
constexpr size_t OFF_QN = OFF_VAT + al((size_t)NBATCH * 6 * NKEY * 64 * 2);
constexpr size_t OFF_QNC = OFF_QN + al((size_t)NBATCH * 6 * SEQ * 64 * 2);
constexpr size_t OFF_KN = OFF_QNC + al((size_t)NBATCH * 6 * LCTX * 64 * 2);
constexpr size_t OFF_VNT = OFF_KN + al((size_t)NBATCH * 6 * NKEY * 64 * 2);
constexpr size_t OFF_U = OFF_VNT + al((size_t)NBATCH * 6 * NKEY * 64 * 2);
constexpr size_t OFF_XS5 = OFF_U + al((size_t)TT * 256 * 2);
constexpr size_t OFF_ES5 = OFF_XS5 + al((size_t)16 * 1088 * 768 * 2);
constexpr size_t OFF_GBUF = OFF_ES5 + al((size_t)16 * 1088 * 256 * 2);
constexpr size_t OFF_MIXEND = OFF_GBUF + al((size_t)TT * 256 * 2);
constexpr size_t OFF_YK = OFF_W1;
constexpr size_t OFF_ACT = OFF_YK + al((size_t)(THALF + 1) * 10240);
constexpr size_t OFF_ACTSH = OFF_ACT + al((size_t)MAXROWS * 256 * 2);
constexpr size_t OFF_MOEEND = OFF_ACTSH + al((size_t)TT * 256 * 2);
constexpr size_t WS_NEED = OFF_MIXEND > OFF_MOEEND ? OFF_MIXEND : OFF_MOEEND;

constexpr int LDS_BYTES = 160 * 1024;
constexpr int CS_STRIDE = 264;

struct Params {
    const float* in[35];
    float* out;
    char* ws;
    int layer;
    int sub;
};

enum { I_X = 0, I_C, I_CTX, I_CCTX, I_WMOD, I_BMOD, I_GMIX, I_GFFN, I_WIN, I_WOUT, I_AGQ, I_AGK, I_ALAM, I_AGSUB, I_NGQ, I_NGK, I_NRPB,
       I_S5ARE, I_S5AIM, I_S5LDT, I_S5BRE, I_S5BIM, I_S5CRE, I_S5CIM, I_S5D, I_S5WGLU, I_S5BGLU, I_WROUTER, I_EBIAS, I_WGATE, I_WUP, I_WDOWN,
       I_WSGATE, I_WSUP, I_WSDOWN };

struct Params;
typedef __attribute__((address_space(1))) char g1char;
DEV char* opaque_ptr(char* p) { g1char* g = (g1char*)p; asm volatile("" : "+s"(g)); return (char*)g; }
DEV int opaque_s(int x) { asm volatile("" : "+s"(x)); return x; }
extern __shared__ __attribute__((aligned(16))) char lds_dyn[];
constexpr int LDS_TID_TABLE = 160 * 1024 - 16 - 64;
DEV unsigned hw_wave_slot() { return (unsigned)__builtin_amdgcn_s_getreg((5 << 11) | 4) & 63u; }
DEV int plain_tid() {
    const int wv = __builtin_amdgcn_readfirstlane((int)((volatile LAS unsigned char*)(LAS char*)lds_dyn)[LDS_TID_TABLE + hw_wave_slot()]);
    int lane;
    asm volatile("v_mbcnt_lo_u32_b32 %0, -1, 0\n\tv_mbcnt_hi_u32_b32 %0, -1, %0" : "=v"(lane));
    return (wv << 6) | lane;
}
DEV int opaque_tid() { int t = plain_tid(); asm volatile("" : "+v"(t)); return t; }

DEV float bf2f(u16 b) { return __uint_as_float(((u32)b) << 16); }
DEV u16 f2bf(float f) { u32 u = __float_as_uint(f); u += 0x7FFFu + ((u >> 16) & 1u); return (u16)(u >> 16); }
typedef __bf16 bf16v2_t __attribute__((ext_vector_type(2)));
typedef float f32v2_t __attribute__((ext_vector_type(2)));
DEV u32 cvt_pk_bf16(float lo, float hi) { f32v2_t v = {lo, hi}; bf16v2_t b = __builtin_convertvector(v, bf16v2_t); return __builtin_bit_cast(u32, b); }
DEV u32 pack2(float lo, float hi) { return cvt_pk_bf16(lo, hi); }
DEV float wave_sum(float v) {
#pragma unroll
    for (int o = 32; o > 0; o >>= 1) v += __shfl_xor(v, o);
    return v;
}
DEV float silu_f(float x) { return x / (1.f + __expf(-x)); }
DEV float sigmoid_f(float x) { return 1.f / (1.f + __expf(-x)); }
DEV float gelu_tanh(float x) {
    const float k = 0.7978845608028654f;
    float u = k * (x + 0.044715f * x * x * x);
    float t = 1.f - 2.f / (1.f + __expf(2.f * u));
    return 0.5f * x * (1.f + t);
}
DEV void unpack8(const uint4& q, float* f) {
    f[0] = __uint_as_float(q.x << 16); f[1] = __uint_as_float(q.x & 0xFFFF0000u);
    f[2] = __uint_as_float(q.y << 16); f[3] = __uint_as_float(q.y & 0xFFFF0000u);
    f[4] = __uint_as_float(q.z << 16); f[5] = __uint_as_float(q.z & 0xFFFF0000u);
    f[6] = __uint_as_float(q.w << 16); f[7] = __uint_as_float(q.w & 0xFFFF0000u);
}
DEV uint4 pack8(const float* f) {
    uint4 q; q.x = pack2(f[0], f[1]); q.y = pack2(f[2], f[3]); q.z = pack2(f[4], f[5]); q.w = pack2(f[6], f[7]); return q;
}
DEV bool tok_lat(int t) { return t < TL; }
DEV int tok_b(int t) { return t < TL ? (t >> 12) : ((t - TL) >> 8); }
DEV int tok_mb(int t) { return t < TL ? (t >> 12) : 8; }
DEV float lam_init_of(int l) { return l == 0 ? 0.2f : (0.8f - 0.6f * 0.7408182206817179f); }

DEV const float* xrow_prev(const Params& P, int l, int t) {
    char* const wsb = opaque_ptr(P.ws);
    if (t < TL) return (l == 0 ? P.in[I_X] : P.out) + (size_t)t * D;
    return (l == 0 ? P.in[I_CTX] : (const float*)(wsb + OFF_CTXS)) + (size_t)(t - TL) * D;
}
DEV float* xrow_cur(const Params& P, int t) {
    char* const wsb = opaque_ptr(P.ws);
    if (t < TL) return P.out + (size_t)t * D;
    return (float*)(wsb + OFF_CTXS) + (size_t)(t - TL) * D;
}

#define XB_TMO      128
#define XB_XCNT(j)  (256  + 64 * (j))
#define XB_XSUB(j)  (1280 + 64 * (j))
#define XB_XGEN(j)  (2304 + 64 * (j))
#define XB_TOP      3328
#define XB_TOPGEN   3392
#define XCD_BAR_WORDS 3456
#define XB_SPIN_CAP (1u << 22)
typedef __attribute__((address_space(1))) unsigned gu32;
__device__ __forceinline__ unsigned xb_ld(gu32* p)              { return __hip_atomic_load(p, __ATOMIC_RELAXED, __HIP_MEMORY_SCOPE_AGENT); }
__device__ __forceinline__ unsigned xb_add(gu32* p, unsigned v) { return __hip_atomic_fetch_add(p, v, __ATOMIC_RELAXED, __HIP_MEMORY_SCOPE_AGENT); }
__device__ __forceinline__ unsigned xb_xcc_id() { return (unsigned)__builtin_amdgcn_s_getreg((3 << 11) | 20) & 0xFu; }
#define XB_SPIN(cond, bar) do { unsigned _sp = 0; while (cond) { __builtin_amdgcn_s_sleep(1); \
    if ((++_sp & 255u) == 0u) { if (xb_ld(&(bar)[XB_TMO])) break; if (_sp > XB_SPIN_CAP) { xb_add(&(bar)[XB_TMO], 1u); break; } } } } while (0)
struct XcdBarrier { unsigned* bar; unsigned x; volatile LAS unsigned* st; };
__device__ __forceinline__ XcdBarrier xcd_barrier_post(unsigned* bar, volatile LAS unsigned* st) {
    XcdBarrier b; b.bar = bar; b.x = xb_xcc_id(); b.st = st;
    if (plain_tid() == 0) (void)xb_add(&((gu32*)bar)[XB_XCNT(b.x)], 1u);
    return b;
}
__device__ __forceinline__ void xcd_barrier_complete(gu32* bar, unsigned x, unsigned& nloc, unsigned& nx) {
    const unsigned G = gridDim.x * gridDim.y * gridDim.z;
    unsigned sum, cnt, mine, sp = 0u;
    for (;;) {
        sum = 0u; cnt = 0u; mine = 0u;
#pragma unroll
        for (unsigned j = 0; j < 16; ++j) { const unsigned c = xb_ld(&bar[XB_XCNT(j)]); sum += c; cnt += (c > 0u) ? 1u : 0u; mine = (j == x) ? c : mine; }
        if (sum == G) break;
        __builtin_amdgcn_s_sleep(1);
        if ((++sp & 255u) == 0u) { if (xb_ld(&bar[XB_TMO])) break; if (sp > XB_SPIN_CAP) { xb_add(&bar[XB_TMO], 1u); break; } }
    }
    nloc = mine > 0u ? mine : 1u; nx = cnt > 0u ? cnt : 1u;
}
__device__ __forceinline__ void xcd_barrier(const XcdBarrier& b) {
    asm volatile("s_waitcnt vmcnt(0)" ::: "memory");
    __syncthreads();
    if (plain_tid() == 0) {
        gu32* bar = (gu32*)opaque_ptr((char*)b.bar);
        unsigned bx = b.x; asm volatile("" : "+s"(bx));
        __builtin_amdgcn_s_waitcnt(0);
        unsigned nloc = b.st[0], nx = b.st[1];
        if (nloc == 0u) { xcd_barrier_complete(bar, bx, nloc, nx); b.st[0] = nloc; b.st[1] = nx; }
        const unsigned old = xb_add(&bar[XB_XSUB(bx)], 1u);
        const unsigned gen = old / nloc;
        if (old + 1u == (gen + 1u) * nloc) {
            __builtin_amdgcn_fence(__ATOMIC_RELEASE, "agent");
            asm volatile("s_waitcnt vmcnt(0)" ::: "memory");
            const unsigned og = xb_add(&bar[XB_TOP], 1u);
            const unsigned tg = og / nx;
            if (og + 1u == (tg + 1u) * nx) xb_add(&bar[XB_TOPGEN], 1u);
            else XB_SPIN(xb_ld(&bar[XB_TOPGEN]) == tg, bar);
            __builtin_amdgcn_fence(__ATOMIC_ACQUIRE, "agent");
            xb_add(&bar[XB_XGEN(bx)], 1u);
            asm volatile("s_waitcnt vmcnt(0)" ::: "memory");
        } else {
            XB_SPIN(xb_ld(&bar[XB_XGEN(bx)]) == gen, bar);
            __builtin_amdgcn_fence(__ATOMIC_ACQUIRE, "agent");
            asm volatile("s_waitcnt vmcnt(0)" ::: "memory");
        }
    }
    __syncthreads();
}

constexpr int BK = 64, HALF = 128, HT = HALF * BK;

DEV int lds_byte(int r, int c) {
    int st = (r >> 4) * 2 + (c >> 5), rr = r & 15, cc = c & 31, ob = rr * 64 + cc * 2;
    return st * 1024 + (ob ^ (((ob >> 9) & 1) << 5));
}
DEV void stage_rc(int b, int& R, int& C) {
    int st = b / 1024, sb = b % 1024, swz = sb ^ (((sb >> 9) & 1) << 5);
    R = (st >> 1) * 16 + swz / 64; C = (st & 1) * 32 + (swz % 64) / 2;
}

template <class AOff>
DEV void gemm_tile_core(const u16* __restrict__ Abase, AOff aoffA, const u16* __restrict__ Bt, const int Kin, char* lds) {
    const int tidx = opaque_tid();
    u16* Cs = (u16*)lds;
    int K = Kin; asm volatile("" : "+s"(K));
    u16* shm = (u16*)lds;
#define SA(b, h) (shm + ((b) * 2 + (h)) * HT)
#define SB(b, h) (shm + (4 + (b) * 2 + (h)) * HT)
#define STAGE_A(TZ, P, h, kt) do { \
    for (int _i = 0; _i < 2; ++_i) { const int _b = (TZ) * 16 + _i * 8192; \
      __builtin_amdgcn_global_load_lds((const unsigned*)((const char*)Abase + (size_t)(u32)(voa[h][_i] + (u32)(kt) * (BK * 2))), \
        (LAS unsigned*)((LAS char*)(P) + _b), 16, 0, 0); } } while (0)
#define STAGE_B(TZ, P, h, kt) do { const char* _bb = (const char*)(Bt + (size_t)(h) * HALF * K); \
    for (int _i = 0; _i < 2; ++_i) { const int _b = (TZ) * 16 + _i * 8192; \
      __builtin_amdgcn_global_load_lds((const unsigned*)(_bb + (size_t)(u32)(vob[_i] + (u32)(kt) * (BK * 2))), \
        (LAS unsigned*)((LAS char*)(P) + _b), 16, 0, 0); } } while (0)
#define LDA(dst, b, h) for (int m = 0; m < 4; ++m) for (int k = 0; k < 2; ++k) \
    dst[m][k] = *reinterpret_cast<const bf16x8*>((char*)SA(b, h) + lds_byte(wr * 64 + m * 16 + fr, k * 32 + fq * 8))
#define LDB(dst, b, h) for (int n = 0; n < 2; ++n) for (int k = 0; k < 2; ++k) \
    dst[n][k] = *reinterpret_cast<const bf16x8*>((char*)SB(b, h) + lds_byte(wc * 32 + n * 16 + fr, k * 32 + fq * 8))
#define MMA(ai, bj, At, Bx) do { __builtin_amdgcn_s_setprio(1); \
    for (int m = 0; m < 4; ++m) for (int n = 0; n < 2; ++n) for (int k = 0; k < 2; ++k) \
      acc[ai][bj][m][n] = __builtin_amdgcn_mfma_f32_16x16x32_bf16(Bx[n][k], At[m][k], acc[ai][bj][m][n], 0, 0, 0); \
    __builtin_amdgcn_s_setprio(0); } while (0)
#define WAIT_V(n) asm volatile("s_waitcnt vmcnt(" #n ")" ::: "memory")
#define WAIT_L(n) asm volatile("s_waitcnt lgkmcnt(" #n ")" ::: "memory")
#define BAR __builtin_amdgcn_s_barrier()
#define SCHED __builtin_amdgcn_sched_barrier(0)
    int wid = tidx >> 6, lane = tidx & 63, wr = wid >> 2, wc = wid & 3, fr = lane & 15, fq = lane >> 4;
    u32 voa[2][2], vob[2];
    const int tz0 = opaque_tid();
    {
        for (int i = 0; i < 2; ++i) {
            int _b = tz0 * 16 + i * 8192; int _r, _c; stage_rc(_b, _r, _c);
            vob[i] = (u32)(_r * K + _c) * 2u;
            for (int h = 0; h < 2; ++h) voa[h][i] = (aoffA(h * HALF + _r) + (u32)_c) * 2u;
        }
    }
    f32x4 acc[2][2][4][2] = {};
    bf16x8 At[4][2], B0[2][2], B1[2][2];
    const int nt = K / BK;
    __syncthreads();
    STAGE_B(tidx, SB(0, 0), 0, 0); STAGE_A(tidx, SA(0, 0), 0, 0);
    STAGE_B(tidx, SB(0, 1), 1, 0); STAGE_A(tidx, SA(0, 1), 1, 0);
    if (wr == 1) BAR;
    WAIT_V(4); BAR;
    STAGE_B(tidx, SB(1, 0), 0, 1); STAGE_A(tidx, SA(1, 0), 0, 1); STAGE_B(tidx, SB(1, 1), 1, 1);
    WAIT_V(6); BAR;
    for (int t = 0; t < nt - 2; t += 2) {
        LDB(B0, 0, 0); SCHED; LDA(At, 0, 0); STAGE_A(tidx, SA(1, 1), 1, t + 1);
        WAIT_L(8); BAR; WAIT_L(0); MMA(0, 0, At, B0); BAR; SCHED;
        LDB(B1, 0, 1); STAGE_B(tidx, SB(0, 0), 0, t + 2);
        BAR; WAIT_L(0); MMA(0, 1, At, B1); BAR;
        LDA(At, 0, 1); STAGE_A(tidx, SA(0, 0), 0, t + 2);
        BAR; WAIT_L(0); MMA(1, 0, At, B0); BAR; SCHED;
        STAGE_B(tidx, SB(0, 1), 1, t + 2);
        WAIT_V(6); BAR; MMA(1, 1, At, B1); BAR;
        LDB(B0, 1, 0); SCHED; LDA(At, 1, 0); STAGE_A(tidx, SA(0, 1), 1, t + 2);
        WAIT_L(8); BAR; WAIT_L(0); MMA(0, 0, At, B0); BAR; SCHED;
        LDB(B1, 1, 1); STAGE_B(tidx, SB(1, 0), 0, t + 3);
        BAR; WAIT_L(0); MMA(0, 1, At, B1); BAR;
        LDA(At, 1, 1); STAGE_A(tidx, SA(1, 0), 0, t + 3);
        BAR; WAIT_L(0); MMA(1, 0, At, B0); BAR; SCHED;
        STAGE_B(tidx, SB(1, 1), 1, t + 3);
        WAIT_V(6); BAR; MMA(1, 1, At, B1); BAR;
    }
    int tz = tidx; asm volatile("" : "+v"(tz)); wid = tz >> 6; lane = tz & 63; wr = wid >> 2; wc = wid & 3; fr = lane & 15; fq = lane >> 4;
    { LDB(B0, 0, 0); WAIT_V(0); LDA(At, 0, 0); STAGE_A(tz, SA(1, 1), 1, nt - 1);
      BAR; WAIT_L(0); MMA(0, 0, At, B0); BAR;
      LDB(B1, 0, 1); BAR; WAIT_L(0); MMA(0, 1, At, B1); BAR;
      LDA(At, 0, 1); WAIT_V(4); BAR; WAIT_L(0); MMA(1, 0, At, B0); MMA(1, 1, At, B1); BAR; }
    { LDB(B0, 1, 0); LDA(At, 1, 0); WAIT_V(2); BAR; WAIT_L(0); MMA(0, 0, At, B0); BAR;
      LDB(B1, 1, 1); WAIT_V(0); BAR; WAIT_L(0); MMA(0, 1, At, B1); BAR;
      LDA(At, 1, 1); BAR; WAIT_L(0); MMA(1, 0, At, B0); MMA(1, 1, At, B1); BAR; }
    if (wr == 0) BAR;
    __syncthreads();
    for (int ai = 0; ai < 2; ++ai) for (int bj = 0; bj < 2; ++bj) for (int m = 0; m < 4; ++m) for (int n = 0; n < 2; ++n) {
        uint2 pk; pk.x = cvt_pk_bf16(acc[ai][bj][m][n][0], acc[ai][bj][m][n][1]); pk.y = cvt_pk_bf16(acc[ai][bj][m][n][2], acc[ai][bj][m][n][3]);
        *(uint2*)(Cs + (ai * HALF + wr * 64 + m * 16 + fr) * CS_STRIDE + (bj * HALF + wc * 32 + n * 16 + fq * 4)) = pk;
    }
    __syncthreads();
#undef SA
#undef SB
#undef STAGE_A
#undef STAGE_B
#undef LDA
#undef LDB
#undef MMA
}

struct GemmPre { const u16* Abase; const u16* Bt; u32 voa[2][2]; u32 vob[2]; int K; };
template <class AOff>
DEV void gemm_pre_make(GemmPre& g, const u16* Abase, AOff aoffA, const u16* Bt, int K) {
    const int tz0 = opaque_tid();
    g.Abase = Abase; g.Bt = Bt; g.K = K;
#pragma unroll
    for (int i = 0; i < 2; ++i) {
        int _b = tz0 * 16 + i * 8192; int _r, _c; stage_rc(_b, _r, _c);
        g.vob[i] = (u32)(_r * K + _c) * 2u;
#pragma unroll
        for (int h = 0; h < 2; ++h) g.voa[h][i] = (aoffA(h * HALF + _r) + (u32)_c) * 2u;
    }
}
#define GP_STAGE_A(G, P, h, kt) do { \
    for (int _i = 0; _i < 2; ++_i) { const int _b = tidx * 16 + _i * 8192; \
      __builtin_amdgcn_global_load_lds((const unsigned*)((const char*)(G).Abase + (size_t)(u32)((G).voa[h][_i] + (u32)(kt) * (BK * 2))), \
        (LAS unsigned*)((LAS char*)(P) + _b), 16, 0, 0); } } while (0)
#define GP_STAGE_B(G, P, h, kt) do { const char* _bb = (const char*)((G).Bt + (size_t)(h) * HALF * (G).K); \
    for (int _i = 0; _i < 2; ++_i) { const int _b = tidx * 16 + _i * 8192; \
      __builtin_amdgcn_global_load_lds((const unsigned*)(_bb + (size_t)(u32)((G).vob[_i] + (u32)(kt) * (BK * 2))), \
        (LAS unsigned*)((LAS char*)(P) + _b), 16, 0, 0); } } while (0)
DEV void gemm_pre_issue(const GemmPre& g, char* lds) {
    const int tidx = opaque_tid();
    u16* shm = (u16*)lds;
    GP_STAGE_B(g, (shm + (4 + 0) * HT), 0, 0); GP_STAGE_A(g, (shm + 0 * HT), 0, 0);
    GP_STAGE_B(g, (shm + (4 + 1) * HT), 1, 0); GP_STAGE_A(g, (shm + 1 * HT), 1, 0);
}
template <class AfterLoop, class Epi>
DEV void gemm_tile_pipe(const GemmPre& g, char* lds, AfterLoop after_loop, Epi epi) {
    const int tidx = opaque_tid();
    const u16* __restrict__ Abase = g.Abase; const u16* __restrict__ Bt = g.Bt;
    int K = g.K; asm volatile("" : "+s"(K));
    u16* shm = (u16*)lds;
#define SA(b, h) (shm + ((b) * 2 + (h)) * HT)
#define SB(b, h) (shm + (4 + (b) * 2 + (h)) * HT)
#define STAGE_A(TZ, P, h, kt) do { \
    for (int _i = 0; _i < 2; ++_i) { const int _b = (TZ) * 16 + _i * 8192; \
      __builtin_amdgcn_global_load_lds((const unsigned*)((const char*)Abase + (size_t)(u32)(voa[h][_i] + (u32)(kt) * (BK * 2))), \
        (LAS unsigned*)((LAS char*)(P) + _b), 16, 0, 0); } } while (0)
#define STAGE_B(TZ, P, h, kt) do { const char* _bb = (const char*)(Bt + (size_t)(h) * HALF * K); \
    for (int _i = 0; _i < 2; ++_i) { const int _b = (TZ) * 16 + _i * 8192; \
      __builtin_amdgcn_global_load_lds((const unsigned*)(_bb + (size_t)(u32)(vob[_i] + (u32)(kt) * (BK * 2))), \
        (LAS unsigned*)((LAS char*)(P) + _b), 16, 0, 0); } } while (0)
#define LDA(dst, b, h) for (int m = 0; m < 4; ++m) for (int k = 0; k < 2; ++k) \
    dst[m][k] = *reinterpret_cast<const bf16x8*>((char*)SA(b, h) + lds_byte(wr * 64 + m * 16 + fr, k * 32 + fq * 8))
#define LDB(dst, b, h) for (int n = 0; n < 2; ++n) for (int k = 0; k < 2; ++k) \
    dst[n][k] = *reinterpret_cast<const bf16x8*>((char*)SB(b, h) + lds_byte(wc * 32 + n * 16 + fr, k * 32 + fq * 8))
#define MMA(ai, bj, At, Bx) do { __builtin_amdgcn_s_setprio(1); \
    for (int m = 0; m < 4; ++m) for (int n = 0; n < 2; ++n) for (int k = 0; k < 2; ++k) \
      acc[ai][bj][m][n] = __builtin_amdgcn_mfma_f32_16x16x32_bf16(Bx[n][k], At[m][k], acc[ai][bj][m][n], 0, 0, 0); \
    __builtin_amdgcn_s_setprio(0); } while (0)
#define WAIT_V(n) asm volatile("s_waitcnt vmcnt(" #n ")" ::: "memory")
#define WAIT_L(n) asm volatile("s_waitcnt lgkmcnt(" #n ")" ::: "memory")
#define BAR __builtin_amdgcn_s_barrier()
#define SCHED __builtin_amdgcn_sched_barrier(0)
    int wid = tidx >> 6, lane = tidx & 63, wr = wid >> 2, wc = wid & 3, fr = lane & 15, fq = lane >> 4;
    u32 voa[2][2], vob[2];
    voa[0][0] = g.voa[0][0]; voa[0][1] = g.voa[0][1]; voa[1][0] = g.voa[1][0]; voa[1][1] = g.voa[1][1]; vob[0] = g.vob[0]; vob[1] = g.vob[1];
    f32x4 acc[2][2][4][2] = {};
    bf16x8 At[4][2], B0[2][2], B1[2][2];
    const int nt = K / BK;
    if (wr == 1) BAR;
    WAIT_V(4); BAR;
    STAGE_B(tidx, SB(1, 0), 0, 1); STAGE_A(tidx, SA(1, 0), 0, 1); STAGE_B(tidx, SB(1, 1), 1, 1);
    WAIT_V(6); BAR;
    for (int t = 0; t < nt - 2; t += 2) {
        LDB(B0, 0, 0); SCHED; LDA(At, 0, 0); STAGE_A(tidx, SA(1, 1), 1, t + 1);
        WAIT_L(8); BAR; WAIT_L(0); MMA(0, 0, At, B0); BAR; SCHED;
        LDB(B1, 0, 1); STAGE_B(tidx, SB(0, 0), 0, t + 2);
        BAR; WAIT_L(0); MMA(0, 1, At, B1); BAR;
        LDA(At, 0, 1); STAGE_A(tidx, SA(0, 0), 0, t + 2);
        BAR; WAIT_L(0); MMA(1, 0, At, B0); BAR; SCHED;
        STAGE_B(tidx, SB(0, 1), 1, t + 2);
        WAIT_V(6); BAR; MMA(1, 1, At, B1); BAR;
        LDB(B0, 1, 0); SCHED; LDA(At, 1, 0); STAGE_A(tidx, SA(0, 1), 1, t + 2);
        WAIT_L(8); BAR; WAIT_L(0); MMA(0, 0, At, B0); BAR; SCHED;
        LDB(B1, 1, 1); STAGE_B(tidx, SB(1, 0), 0, t + 3);
        BAR; WAIT_L(0); MMA(0, 1, At, B1); BAR;
        LDA(At, 1, 1); STAGE_A(tidx, SA(1, 0), 0, t + 3);
        BAR; WAIT_L(0); MMA(1, 0, At, B0); BAR; SCHED;
        STAGE_B(tidx, SB(1, 1), 1, t + 3);
        WAIT_V(6); BAR; MMA(1, 1, At, B1); BAR;
    }
    int tz = tidx; asm volatile("" : "+v"(tz)); wid = tz >> 6; lane = tz & 63; wr = wid >> 2; wc = wid & 3; fr = lane & 15; fq = lane >> 4;
    { LDB(B0, 0, 0); WAIT_V(0); LDA(At, 0, 0); STAGE_A(tz, SA(1, 1), 1, nt - 1);
      BAR; WAIT_L(0); MMA(0, 0, At, B0); BAR;
      LDB(B1, 0, 1); BAR; WAIT_L(0); MMA(0, 1, At, B1); BAR;
      LDA(At, 0, 1); WAIT_V(4); BAR; WAIT_L(0); MMA(1, 0, At, B0); MMA(1, 1, At, B1); BAR; }
    { LDB(B0, 1, 0); LDA(At, 1, 0); WAIT_V(2); BAR; WAIT_L(0); MMA(0, 0, At, B0); BAR;
      LDB(B1, 1, 1); WAIT_V(0); BAR; WAIT_L(0); MMA(0, 1, At, B1); BAR;
      LDA(At, 1, 1); BAR; WAIT_L(0); MMA(1, 0, At, B0); MMA(1, 1, At, B1); BAR; }
    if (wr == 0) BAR;
    __syncthreads();
    after_loop();
    epi(acc, wr, wc, fr, fq);
#undef SA
#undef SB
#undef STAGE_A
#undef STAGE_B
#undef LDA
#undef LDB
#undef MMA
}


DEV void convert_tile(const float* __restrict__ src, u16* __restrict__ dst, int K, int N, int mode, int tile, char* lds) {
    const int tidx = opaque_tid();
    float* tl = (float*)lds;
    const int ntn = N / 64;
    const int tk = tile / ntn, tn = tile % ntn;
    const int t = tidx;
    __syncthreads();
    {
        const int kk = t >> 4, n4 = (t & 15) * 4;
#pragma unroll
        for (int i = 0; i < 2; ++i) {
            const int k = kk + i * 32;
            const float4 v = *(const float4*)(src + (size_t)(tk * 64 + k) * N + tn * 64 + n4);
            tl[k * 65 + n4 + 0] = v.x; tl[k * 65 + n4 + 1] = v.y; tl[k * 65 + n4 + 2] = v.z; tl[k * 65 + n4 + 3] = v.w;
        }
    }
    __syncthreads();
    {
        const int n = t >> 3, k8 = (t & 7) * 8;
        float f[8];
#pragma unroll
        for (int i = 0; i < 8; ++i) f[i] = tl[(k8 + i) * 65 + n];
        const int c = tn * 64 + n;
        int row = c;
        if (mode == 1) row = (c >> 7) * 256 + (c & 127);
        else if (mode == 2) row = (c >> 7) * 256 + 128 + (c & 127);
        *(uint4*)(dst + (size_t)row * K + tk * 64 + k8) = pack8(f);
    }
}
DEV void convert_set(const float* src, size_t src_mat_stride, u16* dst, size_t dst_mat_stride, int nmat, int K, int N, int mode, int bid, int nb, char* lds) {
    const int tpm = (K / 64) * (N / 64);
    for (int i = bid; i < nmat * tpm; i += nb) {
        const int m = i / tpm, tile = i % tpm;
        convert_tile(src + (size_t)m * src_mat_stride, dst + (size_t)m * dst_mat_stride, K, N, mode, tile, lds);
    }
}

DEV void phase_init(const Params& P, int bid, int nb, char* lds) {
    char* const wsb = opaque_ptr(P.ws);
    const int tidx = opaque_tid();
    const int t = tidx;
    convert_set(P.in[I_WIN], (size_t)D * INC, (u16*)(wsb + OFF_WIN), (size_t)INC * D, 2, D, INC, 0, bid, nb, lds);
    convert_set(P.in[I_WOUT], (size_t)D * D, (u16*)(wsb + OFF_WOUT), (size_t)D * D, 2, D, D, 0, bid, nb, lds);
    convert_set(P.in[I_S5WGLU], (size_t)256 * 256, (u16*)(wsb + OFF_WGLU), (size_t)256 * 256, 2, 256, 256, 0, bid, nb, lds);
    convert_set(P.in[I_WSGATE], (size_t)D * 256, (u16*)(wsb + OFF_WSH1), (size_t)512 * D, 2, D, 256, 1, bid, nb, lds);
    convert_set(P.in[I_WSUP], (size_t)D * 256, (u16*)(wsb + OFF_WSH1), (size_t)512 * D, 2, D, 256, 2, bid, nb, lds);
    convert_set(P.in[I_WSDOWN], (size_t)256 * D, (u16*)(wsb + OFF_WSH2), (size_t)D * 256, 2, 256, D, 0, bid, nb, lds);
    __syncthreads();
    float* cond = (float*)lds;
    float* red = (float*)(lds + 9 * 1024 * 4);
    for (int i = t; i < 9 * 1024; i += NTHREADS) {
        const int r = i >> 10, k = i & 1023;
        const float v = (r < 8) ? P.in[I_C][r * 1024 + k] : P.in[I_CCTX][k];
        cond[i] = silu_f(v);
    }
    __syncthreads();
    float* mod = (float*)(wsb + OFF_MOD);
    for (int job = bid; job < 192; job += nb) {
        const int l = job / 96, n0 = (job % 96) * 64;
        const int w = t >> 6, lane = t & 63;
        float acc[9];
#pragma unroll
        for (int r = 0; r < 9; ++r) acc[r] = 0.f;
        const float* wm = P.in[I_WMOD] + (size_t)l * D * 6144 + n0 + lane;
#pragma unroll 1
        for (int k0 = w * 128; k0 < (w + 1) * 128; k0 += 16) {
            float wv[16];
#pragma unroll
            for (int kk = 0; kk < 16; ++kk) wv[kk] = wm[(size_t)(k0 + kk) * 6144];
#pragma unroll
            for (int kk = 0; kk < 16; ++kk)
#pragma unroll
                for (int r = 0; r < 9; ++r) acc[r] += cond[r * 1024 + k0 + kk] * wv[kk];
        }
#pragma unroll
        for (int r = 0; r < 9; ++r) red[(w * 9 + r) * 64 + lane] = acc[r];
        __syncthreads();
        for (int i = t; i < 9 * 64; i += NTHREADS) {
            const int r = i >> 6, ln = i & 63;
            float s = 0.f;
#pragma unroll
            for (int ww = 0; ww < 8; ++ww) s += red[(ww * 9 + r) * 64 + ln];
            mod[((size_t)l * 9 + r) * 6144 + n0 + ln] = s + P.in[I_BMOD][l * 6144 + n0 + ln];
        }
        __syncthreads();
    }
    if (bid == 0) {
        float* rope = (float*)(wsb + OFF_ROPE);
        if (t < 512) {
            const int v = t >> 3, i = t & 7;
            const float inv = powf(10000.f, -(float)i / 8.f);
            const float ang = (float)v * inv;
            rope[t] = cosf(ang);
            rope[512 + t] = sinf(ang);
        }
        if (t < 2) {
            const float* lv = P.in[I_ALAM] + t * 4 * 32;
            float s01 = 0.f, s23 = 0.f;
            for (int i = 0; i < 32; ++i) { s01 += lv[i] * lv[32 + i]; s23 += lv[64 + i] * lv[96 + i]; }
            ((float*)(wsb + OFF_MISC))[t] = expf(s01) - expf(s23) + lam_init_of(t);
        }
    }
}

DEV void conv_load(const float* __restrict__ src, int N, int k0, int n0, int tidx, float4 (&v)[8]) {
    const int kk = tidx >> 6, n4 = (tidx & 63) * 4;
#pragma unroll
    for (int i = 0; i < 8; ++i) v[i] = *(const float4*)(src + (size_t)(k0 + kk + i * 8) * N + n0 + n4);
}
DEV void conv_jobs(const Params& P, int l, int i0, int iend, int step, char* lds) {
    char* const wsb = opaque_ptr(P.ws);
    const int tidx = opaque_tid();
    float* tl = (float*)lds;
    f32x4 v[8];
    int i = i0;
    if (i >= iend) return;
    const float* src = nullptr; u16* dst = nullptr; int K = 0, N = 0, mode = 0, k0 = 0, n0 = 0;
#define CONV_LOAD() do { const int _kk = tidx >> 6, _n4 = (tidx & 63) * 4; _Pragma("unroll") for (int _i = 0; _i < 8; ++_i) v[_i] = *(const f32x4*)(src + (size_t)(k0 + _kk + _i * 8) * N + n0 + _n4); } while (0)
#define CONV_JOB(ji) do { const int _mat = (ji) >> 4, _t = (ji) & 15; const int _kind = _mat >> 6, _e = _mat & 63; \
        if (_kind < 2) { src = P.in[_kind == 0 ? I_WGATE : I_WUP] + ((size_t)l * NEXP + _e) * D * 256; dst = (u16*)(wsb + OFF_W1) + (size_t)_e * 512 * D; \
            K = D; N = 256; mode = _kind + 1; k0 = _t * 64; n0 = 0; } \
        else { src = P.in[I_WDOWN] + ((size_t)l * NEXP + _e) * 256 * D; dst = (u16*)(wsb + OFF_W2) + (size_t)_e * D * 256; \
            K = 256; N = D; mode = 0; k0 = (_t >> 2) * 64; n0 = (_t & 3) * 256; } } while (0)
    { CONV_JOB(i); CONV_LOAD(); }
    for (; i < iend; i += step) {
        __syncthreads();
        {
            const int kk = tidx >> 6, n4 = (tidx & 63) * 4;
#pragma unroll
            for (int j = 0; j < 8; ++j) *(f32x4*)(tl + (kk + j * 8) * 260 + n4) = v[j];
        }
        __syncthreads();
        u16* cdst = dst; const int cK = K, cmode = mode, ck0 = k0, cn0 = n0;
        { const int jn = (i + step < iend) ? i + step : i; CONV_JOB(jn); CONV_LOAD(); }
        {
            const int n = tidx & 255, kh = tidx >> 8;
            float f[32];
#pragma unroll
            for (int kk = 0; kk < 32; ++kk) f[kk] = tl[(kh * 32 + kk) * 260 + n];
            const int c = cn0 + n;
            int row = c;
            if (cmode == 1) row = (c >> 7) * 256 + (c & 127);
            else if (cmode == 2) row = (c >> 7) * 256 + 128 + (c & 127);
            u16* o = cdst + (size_t)row * cK + ck0 + kh * 32;
#pragma unroll
            for (int j = 0; j < 4; ++j) *(uint4*)(o + j * 8) = pack8(f + j * 8);
        }
    }
    __syncthreads();
#undef CONV_LOAD
#undef CONV_JOB
}
constexpr int CONV_NJOB = 192 * 16;
constexpr int CONV_Q = 8;
constexpr int cmin(int a, int b) { return a < b ? a : b; }
constexpr int INPROJ_TILES0 = 128 * 10 + 8 * 10, INPROJ_TILES1 = 128 * 10 + 8 * 7, OUTPROJ_TILES0 = 136 * 4;
constexpr int INPROJ_BUSY0 = INPROJ_TILES0 % NBLK, INPROJ_BUSY1 = INPROJ_TILES1 % NBLK, OUTPROJ_BUSY0 = OUTPROJ_TILES0 % NBLK;
constexpr int CONV_J1_0 = cmin((NBLK - INPROJ_BUSY0) * CONV_Q, CONV_NJOB), CONV_J1_1 = cmin((NBLK - INPROJ_BUSY1) * CONV_Q, CONV_NJOB);
constexpr int CONV_J2_0 = cmin(CONV_J1_0 + (NBLK - OUTPROJ_BUSY0) * CONV_Q, CONV_NJOB);
static_assert(INPROJ_BUSY0 > 0 && INPROJ_BUSY1 > 0 && OUTPROJ_BUSY0 > 0 && CONV_J2_0 <= CONV_NJOB && CONV_J1_1 <= CONV_NJOB, "conversion job split");
DEV void phase_prep(const Params& P, int l, int bid, int nb, char* lds) {
    char* const wsb = opaque_ptr(P.ws);
    const int tidx = opaque_tid();
    conv_jobs(P, l, (l == 0 ? CONV_J2_0 : CONV_J1_1) + bid, CONV_NJOB, nb, lds);
    const int w = tidx >> 6, lane = tidx & 63;
    const float* mod = (const float*)(wsb + OFF_MOD) + (size_t)l * 9 * 6144;
    const float* g = P.in[I_GMIX] + l * D;
    u16* hb = (u16*)(wsb + OFF_HBUF);
    int tk = bid * 8 + w;
    float4 v[4];
    {
        const float* xr = xrow_prev(P, l, tk < TT ? tk : 0);
#pragma unroll
        for (int i = 0; i < 4; ++i) v[i] = *(const float4*)(xr + lane * 4 + i * 256);
    }
    for (; tk < TT; tk += nb * 8) {
        float4 c4[4];
#pragma unroll
        for (int i = 0; i < 4; ++i) c4[i] = v[i];
        {
            const int tn = tk + nb * 8;
            const float* xr = xrow_prev(P, l, tn < TT ? tn : tk);
#pragma unroll
            for (int i = 0; i < 4; ++i) v[i] = *(const float4*)(xr + lane * 4 + i * 256);
        }
        const float* mrow = mod + (size_t)tok_mb(tk) * 6144;
        float ss = 0.f;
#pragma unroll
        for (int i = 0; i < 4; ++i) ss += c4[i].x * c4[i].x + c4[i].y * c4[i].y + c4[i].z * c4[i].z + c4[i].w * c4[i].w;
        ss = wave_sum(ss);
        const float rinv = rsqrtf(ss * (1.f / 1024.f) + EPS);
#pragma unroll
        for (int i = 0; i < 4; ++i) {
            const int c = lane * 4 + i * 256;
            const float4 gg = *(const float4*)(g + c);
            const float4 sh = *(const float4*)(mrow + c);
            const float4 sc = *(const float4*)(mrow + 1024 + c);
            uint2 o;
            o.x = pack2(c4[i].x * rinv * gg.x * (1.f + sc.x) + sh.x, c4[i].y * rinv * gg.y * (1.f + sc.y) + sh.y);
            o.y = pack2(c4[i].z * rinv * gg.z * (1.f + sc.z) + sh.z, c4[i].w * rinv * gg.w * (1.f + sc.w) + sh.w);
            *(uint2*)(hb + (size_t)tk * D + c) = o;
        }
    }
}

DEV void rope32(float* y, const float* rope, int row, int col) {
#pragma unroll
    for (int hf = 0; hf < 2; ++hf) {
        const int pv = hf == 0 ? row : col;
        const float* cs = rope + pv * 8;
        const float* sn = rope + 512 + pv * 8;
#pragma unroll
        for (int i = 0; i < 8; ++i) {
            const float x1 = y[hf * 16 + i], x2 = y[hf * 16 + 8 + i];
            const float c = cs[i], s = sn[i];
            y[hf * 16 + i] = x1 * c - x2 * s;
            y[hf * 16 + 8 + i] = x1 * s + x2 * c;
        }
    }
}

DEV void inproj_epilogue(const Params& P, int l, int mt, int nt_, char* lds) {
    char* const wsb = opaque_ptr(P.ws);
    const u16* Cs = (const u16*)lds;
    const int t = opaque_tid();
    const bool lat = mt < 128;
    const int b = lat ? (mt >> 4) : (mt - 128);
    const int pos0 = lat ? (mt & 15) * 256 : 0;
    const float* rope = (const float*)(wsb + OFF_ROPE);
    for (int hs = 0; hs < 2; ++hs) {
        const int c0 = nt_ * 256 + hs * 128;
        int seg, segstart;
        if (c0 < 384) { seg = 0; segstart = 0; } else if (c0 < 768) { seg = 1; segstart = 384; } else if (c0 < 1152) { seg = 2; segstart = 768; }
        else if (c0 < 1536) { seg = 3; segstart = 1152; } else if (c0 < 1920) { seg = 4; segstart = 1536; } else if (c0 < 2304) { seg = 5; segstart = 1920; }
        else { seg = 6; segstart = 2304; }
        if (seg == 3 || seg == 5) {
            const int col = t & 127, tq = t >> 7;
            const int hh = (c0 - segstart) / 64 + (col >> 6), dv = col & 63;
            u16* vt = (u16*)(wsb + (seg == 3 ? OFF_VAT : OFF_VNT)) + ((size_t)(b * 6 + hh) * 64 + dv) * NKEY + (lat ? pos0 : SEQ);
#pragma unroll
            for (int g16 = 0; g16 < 4; ++g16) {
                const int r0 = tq * 64 + g16 * 16;
                u16 v[16];
#pragma unroll
                for (int i = 0; i < 16; ++i) v[i] = Cs[(r0 + i) * CS_STRIDE + hs * 128 + col];
                uint4 q0, q1;
                q0.x = (u32)v[0] | ((u32)v[1] << 16);   q0.y = (u32)v[2] | ((u32)v[3] << 16);
                q0.z = (u32)v[8] | ((u32)v[9] << 16);   q0.w = (u32)v[10] | ((u32)v[11] << 16);
                q1.x = (u32)v[4] | ((u32)v[5] << 16);   q1.y = (u32)v[6] | ((u32)v[7] << 16);
                q1.z = (u32)v[12] | ((u32)v[13] << 16); q1.w = (u32)v[14] | ((u32)v[15] << 16);
                *(uint4*)(vt + r0) = q0;
                *(uint4*)(vt + r0 + 8) = q1;
            }
        } else {
            const int r = t >> 1, sub = t & 1;
            const int pos = pos0 + r;
            float v[64];
#pragma unroll
            for (int i = 0; i < 8; ++i) unpack8(*(const uint4*)(Cs + r * CS_STRIDE + hs * 128 + sub * 64 + i * 8), v + i * 8);
            const int hh = (c0 - segstart) / 64 + sub;
            if (seg == 0 || seg == 2) {
                const float* g = P.in[seg == 0 ? I_AGQ : I_AGK] + l * 32;
                const float qs = seg == 0 ? 0.17677669529663687f * LOG2E : 1.f;
#pragma unroll
                for (int s = 0; s < 2; ++s) {
                    float ss = 0.f;
#pragma unroll
                    for (int i = 0; i < 32; ++i) ss += v[s * 32 + i] * v[s * 32 + i];
                    const float rinv = rsqrtf(ss * (1.f / 32.f) + EPS);
#pragma unroll
                    for (int i = 0; i < 32; ++i) v[s * 32 + i] = v[s * 32 + i] * rinv * g[i];
                    if (lat) rope32(v + s * 32, rope, pos >> 6, pos & 63);
#pragma unroll
                    for (int i = 0; i < 32; ++i) v[s * 32 + i] *= qs;
                }
                if (seg == 0) {
#pragma unroll
                    for (int s = 0; s < 2; ++s) {
                        u16* dst = lat ? (u16*)(wsb + OFF_QA) + ((size_t)((b * 6 + hh) * 2 + s) * SEQ + pos) * 32
                                       : (u16*)(wsb + OFF_QAC) + ((size_t)((b * 6 + hh) * 2 + s) * LCTX + pos) * 32;
#pragma unroll
                        for (int i = 0; i < 4; ++i) *(uint4*)(dst + i * 8) = pack8(v + s * 32 + i * 8);
                    }
                } else {
                    const int key = lat ? pos : SEQ + pos;
                    u16* dst = (u16*)(wsb + OFF_KA) + ((size_t)(b * 6 + hh) * NKEY + key) * 64;
#pragma unroll
                    for (int i = 0; i < 8; ++i) *(uint4*)(dst + i * 8) = pack8(v + i * 8);
                }
            } else if (seg == 1 || seg == 4) {
                const float* g = P.in[seg == 1 ? I_NGQ : I_NGK] + l * 64;
                const float qs = seg == 1 ? 0.125f * LOG2E : 1.f;
                float ss = 0.f;
#pragma unroll
                for (int i = 0; i < 64; ++i) ss += v[i] * v[i];
                const float rinv = rsqrtf(ss * (1.f / 64.f) + EPS) * qs;
#pragma unroll
                for (int i = 0; i < 64; ++i) v[i] = v[i] * rinv * g[i];
                u16* dst;
                if (seg == 1) dst = lat ? (u16*)(wsb + OFF_QN) + ((size_t)(b * 6 + hh) * SEQ + pos) * 64 : (u16*)(wsb + OFF_QNC) + ((size_t)(b * 6 + hh) * LCTX + pos) * 64;
                else dst = (u16*)(wsb + OFF_KN) + ((size_t)(b * 6 + hh) * NKEY + (lat ? pos : SEQ + pos)) * 64;
#pragma unroll
                for (int i = 0; i < 8; ++i) *(uint4*)(dst + i * 8) = pack8(v + i * 8);
            } else {
                const int tok = mt * 256 + r;
                u16* dst = (u16*)(wsb + OFF_U) + (size_t)tok * 256 + (c0 - segstart) + sub * 64;
#pragma unroll
                for (int i = 0; i < 8; ++i) *(uint4*)(dst + i * 8) = pack8(v + i * 8);
                {
                    const int fch = lat ? 8 + (pos >> 5) : (pos >> 5), tau = pos & 31;
                    const int g0 = ((c0 - segstart) + sub * 64) >> 4;
#pragma unroll
                    for (int gi = 0; gi < 4; ++gi) {
                        u16* xd = (u16*)(wsb + OFF_XS5) + ((size_t)(g0 + gi) * 1088 + b * 136 + fch) * 768 + 256 + tau * 16;
                        *(uint4*)(xd) = pack8(v + gi * 16);
                        *(uint4*)(xd + 8) = pack8(v + gi * 16 + 8);
                    }
                }
            }
        }
    }
}

DEV void phase_inproj(const Params& P, int l, int bid, int nb, char* lds) {
    char* const wsb = opaque_ptr(P.ws);
    const bool last = (l == 1);
    const u16* A = (const u16*)(wsb + OFF_HBUF);
    const u16* W = (const u16*)(wsb + OFF_WIN) + (size_t)l * INC * D;
    const int nlat = 128 * 10;
    const int nctx = 8 * (last ? 7 : 10);
    for (int i = bid; i < nlat + nctx; i += nb) {
        int mt, nt_;
        if (i < nlat) { mt = i / 10; nt_ = i % 10; }
        else { const int j = i - nlat; if (last) { mt = 128 + j / 7; nt_ = 3 + j % 7; } else { mt = 128 + j / 10; nt_ = j % 10; } }
        const int row0 = mt * 256;
        gemm_tile_core(A, [=](int r) -> u32 { return (u32)(row0 + r) * D; }, W + (size_t)nt_ * 256 * D, D, lds);
        inproj_epilogue(P, l, mt, nt_, lds);
    }
    const int busy = last ? INPROJ_BUSY1 : INPROJ_BUSY0;
    if (nb == NBLK && bid >= busy) conv_jobs(P, l, bid - busy, last ? CONV_J1_1 : CONV_J1_0, NBLK - busy, lds);
    else if (nb != NBLK) conv_jobs(P, l, bid, last ? CONV_J1_1 : CONV_J1_0, nb, lds);
}


DEV f32x16 mfma32(bf16x8 a, bf16x8 b, f32x16 c) { return __builtin_amdgcn_mfma_f32_32x32x16_bf16(a, b, c, 0, 0, 0); }
union FragU { bf16x8 v; u32 u[4]; uint4 q; };
constexpr int KV_ROW = 144;
constexpr int KV_TILE = 64 * KV_ROW;
DEV void attnA_unit(const u16* __restrict__ q0p, const u16* __restrict__ q1p, const u16* __restrict__ kbase, const u16* __restrict__ vbase,
                    int kt0, int kt1, u16* __restrict__ outp, float lam, float li, const float* __restrict__ gsub, char* lds, int tidx_unused) {
    const int tidx = opaque_tid();
    const int w = tidx >> 6, lane = tidx & 63, r = lane & 31, hq = lane >> 5;
    FragU qf[2][2];
#pragma unroll
    for (int ks = 0; ks < 2; ++ks) {
        qf[0][ks].q = *(const uint4*)(q0p + (size_t)(w * 32 + r) * 32 + ks * 16 + hq * 8);
        qf[1][ks].q = *(const uint4*)(q1p + (size_t)(w * 32 + r) * 32 + ks * 16 + hq * 8);
    }
    f32x16 O[2][2];
#pragma unroll
    for (int s = 0; s < 2; ++s)
#pragma unroll
        for (int d = 0; d < 2; ++d)
#pragma unroll
            for (int i = 0; i < 16; ++i) O[s][d][i] = 0.f;
    float rs[2] = {0.f, 0.f};
    const int srow = tidx >> 3, schunk = tidx & 7;
    const u16* kg = kbase + (size_t)srow * 64 + schunk * 8;
    const u16* vg = vbase + (size_t)srow * NKEY + schunk * 8;
    const int soff = srow * KV_ROW + schunk * 16;
    uint4 kreg = *(const uint4*)(kg + (size_t)kt0 * 64 * 64);
    uint4 vreg = *(const uint4*)(vg + (size_t)kt0 * 64);
    __syncthreads();
    for (int t = kt0; t < kt1; ++t) {
        char* Ks = lds + ((t - kt0) & 1) * (2 * KV_TILE);
        char* Vs = Ks + KV_TILE;
        *(uint4*)(Ks + soff) = kreg;
        *(uint4*)(Vs + soff) = vreg;
        __syncthreads();
        if (t + 1 < kt1) {
            kreg = *(const uint4*)(kg + (size_t)(t + 1) * 64 * 64);
            vreg = *(const uint4*)(vg + (size_t)(t + 1) * 64);
        }
        bf16x8 vf[2][4];
#pragma unroll
        for (int d = 0; d < 2; ++d)
#pragma unroll
            for (int g = 0; g < 4; ++g) vf[d][g] = *(const bf16x8*)(Vs + (d * 32 + r) * KV_ROW + (g * 16 + hq * 8) * 2);
#pragma unroll
        for (int s = 0; s < 2; ++s) {
            FragU pf[2][2];
#pragma unroll
            for (int kt = 0; kt < 2; ++kt) {
                f32x16 acc;
#pragma unroll
                for (int i = 0; i < 16; ++i) acc[i] = 0.f;
#pragma unroll
                for (int ks = 0; ks < 2; ++ks) {
                    FragU kf; kf.q = *(const uint4*)(Ks + (kt * 32 + r) * KV_ROW + s * 64 + ks * 32 + hq * 16);
                    acc = mfma32(kf.v, qf[s][ks].v, acc);
                }
                float p[16];
#pragma unroll
                for (int i = 0; i < 16; ++i) { p[i] = __builtin_amdgcn_exp2f(acc[i]); rs[s] += p[i]; }
#pragma unroll
                for (int s2 = 0; s2 < 2; ++s2)
#pragma unroll
                    for (int j = 0; j < 4; ++j) pf[kt][s2].u[j] = cvt_pk_bf16(p[s2 * 8 + j * 2], p[s2 * 8 + j * 2 + 1]);
            }
#pragma unroll
            for (int d = 0; d < 2; ++d)
#pragma unroll
                for (int kt = 0; kt < 2; ++kt)
#pragma unroll
                    for (int s2 = 0; s2 < 2; ++s2) O[s][d] = mfma32(vf[d][kt * 2 + s2], pf[kt][s2].v, O[s][d]);
            __builtin_amdgcn_sched_barrier(0);
        }
    }
    const float r0 = rs[0] + __shfl_xor(rs[0], 32), r1 = rs[1] + __shfl_xor(rs[1], 32);
    const float c0 = 1.f / r0, c1 = lam / r1;
    float ss = 0.f;
#pragma unroll
    for (int d = 0; d < 2; ++d)
#pragma unroll
        for (int i = 0; i < 16; ++i) { const float o = O[0][d][i] * c0 - O[1][d][i] * c1; O[0][d][i] = o; ss += o * o; }
    ss += __shfl_xor(ss, 32);
    const float rinv = rsqrtf(ss * (1.f / 64.f) + EPS) * (1.f - li);
    const int t2 = opaque_tid();
    const int hq2 = (t2 >> 5) & 1;
    u16* op = outp + (size_t)((t2 >> 6) * 32 + (t2 & 31)) * D;
#pragma unroll
    for (int d = 0; d < 2; ++d)
#pragma unroll
        for (int g4 = 0; g4 < 4; ++g4) {
            const int dv0 = d * 32 + 8 * g4 + 4 * hq2;
            const float4 gs = *(const float4*)(gsub + dv0);
            uint2 o;
            o.x = pack2(O[0][d][g4 * 4 + 0] * rinv * gs.x, O[0][d][g4 * 4 + 1] * rinv * gs.y);
            o.y = pack2(O[0][d][g4 * 4 + 2] * rinv * gs.z, O[0][d][g4 * 4 + 3] * rinv * gs.w);
            *(uint2*)(op + dv0) = o;
        }
}
DEV void phase_attnA(const Params& P, int l, int bid, int nb, char* lds) {
    char* const wsb = opaque_ptr(P.ws);
    const int tidx = opaque_tid();
    const bool last = (l == 1);
    const float lam = ((const float*)(wsb + OFF_MISC))[l];
    const float li = lam_init_of(l);
    const float* gsub = P.in[I_AGSUB] + l * 64;
    const int nlat = NBATCH * 6 * 16;
    const int nctx = last ? 0 : NBATCH * 6;
    for (int u = bid; u < nlat + nctx; u += nb) {
        if (u < nlat) {
            const int ux = u & 7, ui = (u >> 3);
            const int pair = ux * 6 + (ui >> 4), qb = ui & 15;
            const int b = pair / 6, h = pair % 6;
            const u16* q0p = (const u16*)(wsb + OFF_QA) + ((size_t)((b * 6 + h) * 2 + 0) * SEQ + qb * 256) * 32;
            const u16* q1p = (const u16*)(wsb + OFF_QA) + ((size_t)((b * 6 + h) * 2 + 1) * SEQ + qb * 256) * 32;
            attnA_unit(q0p, q1p, (const u16*)(wsb + OFF_KA) + (size_t)(b * 6 + h) * NKEY * 64, (const u16*)(wsb + OFF_VAT) + (size_t)(b * 6 + h) * 64 * NKEY,
                       0, NKEY / 64, (u16*)(wsb + OFF_HBUF) + (size_t)(b * SEQ + qb * 256) * D + h * 64, lam, li, gsub, lds, tidx);
        } else {
            const int j = u - nlat, b = j / 6, h = j % 6;
            const u16* q0p = (const u16*)(wsb + OFF_QAC) + ((size_t)((b * 6 + h) * 2 + 0) * LCTX) * 32;
            const u16* q1p = (const u16*)(wsb + OFF_QAC) + ((size_t)((b * 6 + h) * 2 + 1) * LCTX) * 32;
            attnA_unit(q0p, q1p, (const u16*)(wsb + OFF_KA) + (size_t)(b * 6 + h) * NKEY * 64, (const u16*)(wsb + OFF_VAT) + (size_t)(b * 6 + h) * 64 * NKEY,
                       SEQ / 64, NKEY / 64, (u16*)(wsb + OFF_HBUF) + (size_t)(TL + b * LCTX) * D + h * 64, lam, li, gsub, lds, tidx);
        }
    }
}

DEV void phase_attnN(const Params& P, int l, int bid, int nb, char* lds) {
    char* const wsb = opaque_ptr(P.ws);
    const bool last = (l == 1);
    float* part = (float*)lds;
    float* rpbs = (float*)(lds + 8 * 33 * 64 * 4);
    const int nlat = NBATCH * 6 * 16;
    const int nctx = last ? 0 : NBATCH * 6;
    for (int u = bid; u < nlat + nctx; u += nb) {
        const int tidx = opaque_tid();
        const int w = tidx >> 6, lane = tidx & 63, rl = lane & 31, hq = lane >> 5;
        if (u < nlat) {
            const int ux = u & 7, ui = (u >> 3);
            const int pair = ux * 6 + (ui >> 4), rg = ui & 15;
            const int b = pair / 6, h = pair % 6;
            const int r = rg * 4 + (w >> 1), qt = w & 1;
            const int qc = qt * 32 + rl;
            float* rpbs = (float*)(lds + 8 * KV_TILE);
            __syncthreads();
            if (tidx < 480) { const int dr_ = tidx >> 5, dc_ = tidx & 31; rpbs[tidx] = dc_ < 31 ? P.in[I_NRPB][((size_t)l * 6 + h) * 465 + dr_ * 31 + dc_] * LOG2E : -1e30f; }
            const u16* qp = (const u16*)(wsb + OFF_QN) + ((size_t)(b * 6 + h) * SEQ + r * 64 + qc) * 64;
            FragU qf[4];
#pragma unroll
            for (int ks = 0; ks < 4; ++ks) qf[ks].q = *(const uint4*)(qp + ks * 16 + hq * 8);
            const u16* kb = (const u16*)(wsb + OFF_KN) + (size_t)(b * 6 + h) * NKEY * 64;
            const u16* vb = (const u16*)(wsb + OFF_VNT) + (size_t)(b * 6 + h) * 64 * NKEY;
            const int r0 = min(max(r - 4, 0), 56), cs = min(max(qc - 8, 0), 48);
            const int r0min = min(max(rg * 4 - 4, 0), 56), r0max = min(max(rg * 4 - 1, 0), 56);
            const int nloc = r0max - r0min + 8, nst = nloc + 4;
            int bidx[2][16];
#pragma unroll
            for (int ct = 0; ct < 2; ++ct)
#pragma unroll
                for (int i2 = 0; i2 < 16; ++i2) {
                    const int kc = ct * 32 + (i2 & 3) + 8 * (i2 >> 2) + 4 * hq;
                    const bool valid = (kc >= cs) && (kc < cs + 16);
                    bidx[ct][i2] = (valid ? kc - qc + 15 : 31) * 4;
                }
            f32x16 O[2];
#pragma unroll
            for (int d = 0; d < 2; ++d)
#pragma unroll
                for (int i = 0; i < 16; ++i) O[d][i] = 0.f;
            float rs = 0.f;
            const int srow = tidx >> 3, schunk = tidx & 7;
            const int soff = srow * KV_ROW + schunk * 16;
#define NA_SKEY(st) ((st) < nloc ? (r0min + (st)) * 64 : SEQ + ((st) - nloc) * 64)
            u32x4 kreg0, vreg0, kreg1, vreg1;
            {
                const int k0_ = NA_SKEY(0), k1_ = NA_SKEY(1);
                kreg0 = *(const u32x4*)(kb + (size_t)(k0_ + srow) * 64 + schunk * 8); vreg0 = *(const u32x4*)(vb + (size_t)srow * NKEY + k0_ + schunk * 8);
                kreg1 = *(const u32x4*)(kb + (size_t)(k1_ + srow) * 64 + schunk * 8); vreg1 = *(const u32x4*)(vb + (size_t)srow * NKEY + k1_ + schunk * 8);
            }
            __syncthreads();
            for (int st = 0; st < nst; st += 2) {
                char* St = lds + ((st >> 1) & 1) * (4 * KV_TILE);
                *(u32x4*)(St + soff) = kreg0;
                *(u32x4*)(St + KV_TILE + soff) = vreg0;
                *(u32x4*)(St + 2 * KV_TILE + soff) = kreg1;
                *(u32x4*)(St + 3 * KV_TILE + soff) = vreg1;
                __syncthreads();
                if (st + 2 < nst) {
                    const int k0_ = NA_SKEY(st + 2), k1_ = NA_SKEY(st + 3 < nst ? st + 3 : st + 2);
                    kreg0 = *(const u32x4*)(kb + (size_t)(k0_ + srow) * 64 + schunk * 8); vreg0 = *(const u32x4*)(vb + (size_t)srow * NKEY + k0_ + schunk * 8);
                    kreg1 = *(const u32x4*)(kb + (size_t)(k1_ + srow) * 64 + schunk * 8); vreg1 = *(const u32x4*)(vb + (size_t)srow * NKEY + k1_ + schunk * 8);
                }
#pragma unroll 1
                for (int h2 = 0; h2 < 2; ++h2) {
                    const int sc = st + h2;
                    if (sc >= nst) break;
                    const char* Ks = St + h2 * 2 * KV_TILE;
                    const char* Vs = Ks + KV_TILE;
                    const bool local = sc < nloc;
                    const int kr = r0min + sc;
                    if (!local || (kr >= r0 && kr < r0 + 8)) {
                        const char* rrow = (const char*)rpbs + (kr - r + 7) * 128;
#pragma unroll
                        for (int ct = 0; ct < 2; ++ct) {
                            f32x16 acc;
#pragma unroll
                            for (int i2 = 0; i2 < 16; ++i2) acc[i2] = 0.f;
#pragma unroll
                            for (int ks = 0; ks < 4; ++ks) {
                                const bf16x8 kf = *(const bf16x8*)(Ks + (ct * 32 + rl) * KV_ROW + ks * 32 + hq * 16);
                                acc = mfma32(kf, qf[ks].v, acc);
                            }
                            float p[16];
                            if (local) {
#pragma unroll
                                for (int i2 = 0; i2 < 16; ++i2) { const float v = __builtin_amdgcn_exp2f(acc[i2] + *(const float*)(rrow + bidx[ct][i2])); p[i2] = v; rs += v; }
                            } else {
#pragma unroll
                                for (int i2 = 0; i2 < 16; ++i2) { const float v = __builtin_amdgcn_exp2f(acc[i2]); p[i2] = v; rs += v; }
                            }
                            FragU pf[2];
#pragma unroll
                            for (int s2 = 0; s2 < 2; ++s2)
#pragma unroll
                                for (int j2 = 0; j2 < 4; ++j2) pf[s2].u[j2] = cvt_pk_bf16(p[s2 * 8 + j2 * 2], p[s2 * 8 + j2 * 2 + 1]);
#pragma unroll
                            for (int d = 0; d < 2; ++d)
#pragma unroll
                                for (int s2 = 0; s2 < 2; ++s2) {
                                    const bf16x8 vf = *(const bf16x8*)(Vs + (d * 32 + rl) * KV_ROW + ((ct * 2 + s2) * 16 + hq * 8) * 2);
                                    O[d] = mfma32(vf, pf[s2].v, O[d]);
                                }
                        }
                    }
                }
            }
#undef NA_SKEY
            rs += __shfl_xor(rs, 32);
            const float inv = 1.f / rs;
            u16* op = (u16*)(wsb + OFF_HBUF) + (size_t)(b * SEQ + r * 64 + qc) * D + 640 + h * 64;
#pragma unroll
            for (int d = 0; d < 2; ++d)
#pragma unroll
                for (int g4 = 0; g4 < 4; ++g4) {
                    const int dv0 = d * 32 + 8 * g4 + 4 * hq;
                    uint2 o;
                    o.x = pack2(O[d][g4 * 4 + 0] * inv, O[d][g4 * 4 + 1] * inv);
                    o.y = pack2(O[d][g4 * 4 + 2] * inv, O[d][g4 * 4 + 3] * inv);
                    *(uint2*)(op + dv0) = o;
                }
        } else {
            const int j = u - nlat, b = j / 6, h = j % 6;
            const u16* qp = (const u16*)(wsb + OFF_QNC) + ((size_t)(b * 6 + h) * LCTX + w * 32 + rl) * 64;
            FragU qf[4];
#pragma unroll
            for (int ks = 0; ks < 4; ++ks) qf[ks].q = *(const uint4*)(qp + ks * 16 + hq * 8);
            const u16* kb = (const u16*)(wsb + OFF_KN) + (size_t)(b * 6 + h) * NKEY * 64;
            const u16* vb = (const u16*)(wsb + OFF_VNT) + (size_t)(b * 6 + h) * 64 * NKEY;
            f32x16 O[2];
#pragma unroll
            for (int d = 0; d < 2; ++d)
#pragma unroll
                for (int i = 0; i < 16; ++i) O[d][i] = 0.f;
            float rs = 0.f;
            for (int tile = 0; tile < 8; ++tile) {
                const int key0 = SEQ + tile * 32;
                f32x16 acc;
#pragma unroll
                for (int i = 0; i < 16; ++i) acc[i] = 0.f;
#pragma unroll
                for (int ks = 0; ks < 4; ++ks) {
                    FragU kf; kf.q = *(const uint4*)(kb + (size_t)(key0 + rl) * 64 + ks * 16 + hq * 8);
                    acc = mfma32(kf.v, qf[ks].v, acc);
                }
                float p[16];
#pragma unroll
                for (int i = 0; i < 16; ++i) { p[i] = __builtin_amdgcn_exp2f(acc[i]); rs += p[i]; }
                FragU pf[2];
#pragma unroll
                for (int s2 = 0; s2 < 2; ++s2)
#pragma unroll
                    for (int jj = 0; jj < 4; ++jj) pf[s2].u[jj] = cvt_pk_bf16(p[s2 * 8 + jj * 2], p[s2 * 8 + jj * 2 + 1]);
#pragma unroll
                for (int d = 0; d < 2; ++d)
#pragma unroll
                    for (int s2 = 0; s2 < 2; ++s2) {
                        FragU vf; vf.q = *(const uint4*)(vb + (size_t)(d * 32 + rl) * NKEY + key0 + s2 * 16 + hq * 8);
                        O[d] = mfma32(vf.v, pf[s2].v, O[d]);
                    }
            }
            rs += __shfl_xor(rs, 32);
            const float inv = 1.f / rs;
            u16* op = (u16*)(wsb + OFF_HBUF) + (size_t)(TL + b * LCTX + w * 32 + rl) * D + 640 + h * 64;
#pragma unroll
            for (int d = 0; d < 2; ++d)
#pragma unroll
                for (int g4 = 0; g4 < 4; ++g4) {
                    const int dv0 = d * 32 + 8 * g4 + 4 * hq;
                    uint2 o;
                    o.x = pack2(O[d][g4 * 4 + 0] * inv, O[d][g4 * 4 + 1] * inv);
                    o.y = pack2(O[d][g4 * 4 + 2] * inv, O[d][g4 * 4 + 3] * inv);
                    *(uint2*)(op + dv0) = o;
                }
        }
    }
}


DEV float2 cmul(float2 a, float2 b) { return make_float2(a.x * b.x - a.y * b.y, a.x * b.y + a.y * b.x); }
DEV void s5_kf_init(const Params& P, int bid, int nb, char* lds) {
    char* const wsb = opaque_ptr(P.ws);
    const int tidx = opaque_tid();
    float2* pw = (float2*)lds;
    float2* bb = pw + 8 * 64;
    float2* cc = bb + 64 * 16;
    float* KF = (float*)(wsb + OFF_KF);
    for (int job = bid; job < 256; job += nb) {
        const int l = job >> 7, g = (job >> 3) & 15, k = (job >> 2) & 1, dq = job & 3;
        const size_t pg = (size_t)(l * 2 + k) * 16 + g;
        __syncthreads();
        {
            const int d = dq * 8 + (tidx >> 6), n = tidx & 63;
            const float are = P.in[I_S5ARE][pg * 64 + n], aim = P.in[I_S5AIM][pg * 64 + n];
            const float dt = expf(P.in[I_S5LDT][pg]);
            const float mag = expf(are * dt * (float)d), ang = aim * dt * (float)d;
            pw[tidx] = make_float2(mag * cosf(ang), mag * sinf(ang));
        }
        for (int i = tidx; i < 64 * 16; i += NTHREADS) {
            const int n = i >> 4, p = i & 15;
            const float are = P.in[I_S5ARE][pg * 64 + n], aim = P.in[I_S5AIM][pg * 64 + n];
            const float dt = expf(P.in[I_S5LDT][pg]);
            const float mag = expf(are * dt);
            const float nr = mag * cosf(aim * dt) - 1.f, ni = mag * sinf(aim * dt);
            const float den = are * are + aim * aim;
            const float2 f = make_float2((nr * are + ni * aim) / den, (ni * are - nr * aim) / den);
            bb[i] = cmul(f, make_float2(P.in[I_S5BRE][(pg * 64 + n) * 16 + p], P.in[I_S5BIM][(pg * 64 + n) * 16 + p]));
        }
        for (int i = tidx; i < 16 * 64; i += NTHREADS) {
            const int p = i >> 6, n = i & 63;
            cc[i] = make_float2(P.in[I_S5CRE][(pg * 16 + p) * 64 + n], P.in[I_S5CIM][(pg * 16 + p) * 64 + n]);
        }
        __syncthreads();
        for (int i = tidx; i < 8 * 256; i += NTHREADS) {
            const int dl = i >> 8, p = (i >> 4) & 15, q = i & 15;
            float acc = 0.f;
            for (int n = 0; n < 64; ++n) {
                const float2 t = cmul(cc[p * 64 + n], pw[dl * 64 + n]);
                const float2 b2 = bb[n * 16 + q];
                acc += t.x * b2.x - t.y * b2.y;
            }
            KF[((pg * 32) + dq * 8 + dl) * 256 + p * 16 + q] = acc;
        }
    }
}
DEV void s5_gen(const Params& P, int l, int bid, int nb, char* lds) {
    char* const wsb = opaque_ptr(P.ws);
    const int tidx = opaque_tid();
    float2* pw = (float2*)lds;
    float2* bb = pw + 2 * 33 * 64;
    float2* cc = bb + 2 * 64 * 16;
    u16* M1 = (u16*)(wsb + OFF_M1);
    u16* M3 = (u16*)(wsb + OFF_M3);
    const float* KF = (const float*)(wsb + OFF_KF);
    for (int job = bid; job < 256; job += nb) {
        const int g = job >> 4, part = job & 15;
        __syncthreads();
        for (int i = tidx; i < 2 * 33 * 64; i += NTHREADS) {
            const int k = i / (33 * 64), d = (i >> 6) % 33, n = i & 63;
            const size_t pg = (size_t)(l * 2 + k) * 16 + g;
            const float are = P.in[I_S5ARE][pg * 64 + n], aim = P.in[I_S5AIM][pg * 64 + n];
            const float dt = expf(P.in[I_S5LDT][pg]);
            const float mag = expf(are * dt * (float)d), ang = aim * dt * (float)d;
            pw[i] = make_float2(mag * cosf(ang), mag * sinf(ang));
        }
        for (int i = tidx; i < 2 * 64 * 16; i += NTHREADS) {
            const int k = i >> 10, n = (i >> 4) & 63, p = i & 15;
            const size_t pg = (size_t)(l * 2 + k) * 16 + g;
            const float are = P.in[I_S5ARE][pg * 64 + n], aim = P.in[I_S5AIM][pg * 64 + n];
            const float dt = expf(P.in[I_S5LDT][pg]);
            const float mag = expf(are * dt);
            const float nr = mag * cosf(aim * dt) - 1.f, ni = mag * sinf(aim * dt);
            const float den = are * are + aim * aim;
            const float2 f = make_float2((nr * are + ni * aim) / den, (ni * are - nr * aim) / den);
            bb[i] = cmul(f, make_float2(P.in[I_S5BRE][(pg * 64 + n) * 16 + p], P.in[I_S5BIM][(pg * 64 + n) * 16 + p]));
        }
        for (int i = tidx; i < 2 * 16 * 64; i += NTHREADS) {
            const int k = i >> 10, p = (i >> 6) & 15, n = i & 63;
            const size_t pg = (size_t)(l * 2 + k) * 16 + g;
            cc[i] = make_float2(P.in[I_S5CRE][(pg * 16 + p) * 64 + n], P.in[I_S5CIM][(pg * 16 + p) * 64 + n]);
        }
        __syncthreads();
        const float* kf0 = KF + ((size_t)(l * 2 + 0) * 16 + g) * 32 * 256;
        const float* kf1 = KF + ((size_t)(l * 2 + 1) * 16 + g) * 32 * 256;
        for (int idx = tidx; idx < 32 * 96; idx += NTHREADS) {
            const int row = part * 32 + idx / 96, c8 = (idx % 96) * 8;
            const int tau = row >> 4, p = row & 15;
            float v[8];
#pragma unroll
            for (int j = 0; j < 8; ++j) {
                const int col = c8 + j;
                if (col < 256) {
                    const int k = col >> 7, im = (col >> 6) & 1, n = col & 63;
                    const int d = (k == 0) ? tau + 1 : 32 - tau;
                    const float2 t = cmul(cc[(k * 16 + p) * 64 + n], pw[(k * 33 + d) * 64 + n]);
                    v[j] = im ? -t.y : t.x;
                } else {
                    const int sg = (col - 256) >> 4, q = col & 15;
                    float x = 0.f;
                    if (sg <= tau) x += kf0[(tau - sg) * 256 + p * 16 + q];
                    if (sg >= tau) x += kf1[(sg - tau) * 256 + p * 16 + q];
                    v[j] = x;
                }
            }
            *(uint4*)(M3 + ((size_t)g * 512 + row) * 768 + c8) = pack8(v);
        }
        for (int idx = tidx; idx < 16 * 64; idx += NTHREADS) {
            const int row = part * 16 + (idx >> 6), c8 = (idx & 63) * 8;
            const int k = row >> 7, im = (row >> 6) & 1, n = row & 63;
            float v[8];
#pragma unroll
            for (int j = 0; j < 8; ++j) {
                const int col = c8 + j, tau = col >> 4, p = col & 15;
                const int d = (k == 0) ? 31 - tau : tau;
                const float2 t = cmul(pw[(k * 33 + d) * 64 + n], bb[(k * 64 + n) * 16 + p]);
                v[j] = im ? t.y : t.x;
            }
            *(uint4*)(M1 + ((size_t)g * 256 + row) * 512 + c8) = pack8(v);
        }
    }
}
DEV void phase_s5_E(const Params& P, int l, int bid, int nb, char* lds) {
    char* const wsb = opaque_ptr(P.ws);
    const u16* X = (const u16*)(wsb + OFF_XS5);
    for (int i = bid; i < 80; i += nb) {
        const int g = i / 5, row0 = (i % 5) * 256;
        gemm_tile_core(X, [=](int r) -> u32 { return (u32)(g * 1088 + min(row0 + r, 1087)) * 768u + 256u; }, (const u16*)(wsb + OFF_M1) + (size_t)g * 256 * 512, 512, lds);
        const u16* Cs = (const u16*)lds;
        const int te = opaque_tid();
        const int r = te >> 1, ch = (te & 1) * 128;
        const int row = row0 + r;
        if (row < 1088) {
            u16* dst = (u16*)(wsb + OFF_ES5) + ((size_t)g * 1088 + row) * 256 + ch;
#pragma unroll
            for (int c = 0; c < 128; c += 8) *(uint4*)(dst + c) = *(const uint4*)(Cs + r * CS_STRIDE + ch + c);
        }
    }
}
DEV void phase_s5_carry(const Params& P, int l, int bid, int nb) {
    char* const wsb = opaque_ptr(P.ws);
    const int tidx = opaque_tid();
    if (tidx < 64) {
        const int n = tidx;
        for (int job = bid; job < 256; job += nb) {
            const int g = job >> 4, b = (job >> 1) & 7, dir = job & 1;
            const size_t pg = (size_t)(l * 2 + dir) * 16 + g;
            const float are = P.in[I_S5ARE][pg * 64 + n], aim = P.in[I_S5AIM][pg * 64 + n];
            const float dt = expf(P.in[I_S5LDT][pg]);
            const float mag = expf(are * dt * 32.f), ang = aim * dt * 32.f;
            const float ar = mag * cosf(ang), ai = mag * sinf(ang);
            const u16* E = (const u16*)(wsb + OFF_ES5) + ((size_t)g * 1088 + b * 136) * 256 + dir * 128 + n;
            u16* X = (u16*)(wsb + OFF_XS5) + ((size_t)g * 1088 + b * 136) * 768 + dir * 128 + n;
            float sr = 0.f, si = 0.f;
            for (int st0 = 0; st0 < 136; st0 += 34) {
                float er[34], ei[34];
#pragma unroll
                for (int j = 0; j < 34; ++j) {
                    const int st = st0 + j;
                    const int row = (dir == 0) ? st : (st < 8 ? 7 - st : 143 - st);
                    er[j] = bf2f(E[(size_t)row * 256]);
                    ei[j] = bf2f(E[(size_t)row * 256 + 64]);
                }
#pragma unroll
                for (int j = 0; j < 34; ++j) {
                    const int st = st0 + j;
                    const int row = (dir == 0) ? st : (st < 8 ? 7 - st : 143 - st);
                    X[(size_t)row * 768] = f2bf(sr);
                    X[(size_t)row * 768 + 64] = f2bf(si);
                    const float nr = ar * sr - ai * si + er[j];
                    const float ni = ar * si + ai * sr + ei[j];
                    sr = nr; si = ni;
                }
            }
        }
    }
}
DEV void phase_s5_Y(const Params& P, int l, int bid, int nb, char* lds) {
    char* const wsb = opaque_ptr(P.ws);
    const bool last = (l == 1);
    const u16* X = (const u16*)(wsb + OFF_XS5);
    for (int i = bid; i < 160; i += nb) {
        const int g = i / 10, row0 = ((i % 10) >> 1) * 256, nt_ = i & 1;
        gemm_tile_core(X, [=](int r) -> u32 { return (u32)(g * 1088 + min(row0 + r, 1087)) * 768u; }, (const u16*)(wsb + OFF_M3) + ((size_t)g * 512 + nt_ * 256) * 768, 768, lds);
        const u16* Cs = (const u16*)lds;
        const int te = opaque_tid();
        const int r = te >> 1, hf = te & 1;
        const int row = row0 + r;
        if (row < 1088) {
            const int b = row / 136, fch = row % 136;
            if (!(last && fch < 8)) {
                const float* dsk = P.in[I_S5D] + l * 256 + g * 16;
                float dk[16];
#pragma unroll
                for (int p = 0; p < 16; ++p) dk[p] = dsk[p];
#pragma unroll 2
                for (int tl = 0; tl < 8; ++tl) {
                    const int tau = nt_ * 16 + hf * 8 + tl;
                    const int tok = fch < 8 ? TL + b * LCTX + fch * 32 + tau : b * SEQ + (fch - 8) * 32 + tau;
                    float y[16], u[16];
                    unpack8(*(const uint4*)(Cs + r * CS_STRIDE + hf * 128 + tl * 16), y);
                    unpack8(*(const uint4*)(Cs + r * CS_STRIDE + hf * 128 + tl * 16 + 8), y + 8);
                    const u16* up = (const u16*)(wsb + OFF_U) + (size_t)tok * 256 + g * 16;
                    unpack8(*(const uint4*)up, u); unpack8(*(const uint4*)(up + 8), u + 8);
#pragma unroll
                    for (int p = 0; p < 16; ++p) y[p] = gelu_tanh(y[p] + dk[p] * u[p]);
                    u16* gp = (u16*)(wsb + OFF_GBUF) + (size_t)tok * 256 + g * 16;
                    *(uint4*)gp = pack8(y); *(uint4*)(gp + 8) = pack8(y + 8);
                }
            }
        }
    }
}
DEV void phase_s5_glu(const Params& P, int l, int bid, int nb, char* lds) {
    char* const wsb = opaque_ptr(P.ws);
    const bool last = (l == 1);
    const int nmt = last ? 128 : 136;
    const u16* G = (const u16*)(wsb + OFF_GBUF);
    const float* bg = P.in[I_S5BGLU] + l * 256;
    const int boff = (!last && nb == NBLK) ? 48 : 0;
    for (int mt = (bid >= boff ? bid - boff : bid + nb - boff); mt < nmt; mt += nb) {
        const int row0 = mt * 256;
        gemm_tile_core(G, [=](int r) -> u32 { return (u32)(row0 + r) * 256u; }, (const u16*)(wsb + OFF_WGLU) + (size_t)l * 256 * 256, 256, lds);
        const u16* Cs = (const u16*)lds;
        const int te = opaque_tid();
        const int r = te >> 1, ch = (te & 1) * 128;
        const int tok = row0 + r;
        u16* dst = (u16*)(wsb + OFF_HBUF) + (size_t)tok * D + 384 + ch;
#pragma unroll 2
        for (int c = 0; c < 128; c += 8) {
            float z[8], gv[8];
            unpack8(*(const uint4*)(Cs + r * CS_STRIDE + ch + c), z);
            unpack8(*(const uint4*)(G + (size_t)tok * 256 + ch + c), gv);
#pragma unroll
            for (int j = 0; j < 8; ++j) z[j] = gv[j] * sigmoid_f(z[j] + bg[ch + c + j]);
            *(uint4*)(dst + c) = pack8(z);
        }
    }
}


DEV void phase_outproj(const Params& P, int l, int bid, int nb, char* lds) {
    char* const wsb = opaque_ptr(P.ws);
    const bool last = (l == 1);
    const u16* A = (const u16*)(wsb + OFF_HBUF);
    const u16* W = (const u16*)(wsb + OFF_WOUT) + (size_t)l * D * D;
    const float* mod = (const float*)(wsb + OFF_MOD) + (size_t)l * 9 * 6144;
    const int nmt = last ? 128 : 136;
    for (int i = bid; i < nmt * 4; i += nb) {
        const int mt = i >> 2, nt_ = i & 3;
        const int row0 = mt * 256;
        gemm_tile_core(A, [=](int r) -> u32 { return (u32)(row0 + r) * D; }, W + (size_t)nt_ * 256 * D, D, lds);
        const u16* Cs = (const u16*)lds;
        const int te = opaque_tid();
        const int r = te >> 1, ch = (te & 1) * 128;
        const int tok = row0 + r;
        const float* xp = xrow_prev(P, l, tok) + nt_ * 256 + ch;
        float* xo = xrow_cur(P, tok) + nt_ * 256 + ch;
        const float* gt = mod + (size_t)tok_mb(tok) * 6144 + 2048 + nt_ * 256 + ch;
#pragma unroll 4
        for (int c = 0; c < 128; c += 8) {
            float y[8]; unpack8(*(const uint4*)(Cs + r * CS_STRIDE + ch + c), y);
            const float4 x0 = *(const float4*)(xp + c), x1 = *(const float4*)(xp + c + 4);
            const float4 g0 = *(const float4*)(gt + c), g1 = *(const float4*)(gt + c + 4);
            float4 o0, o1;
            o0.x = x0.x + g0.x * y[0]; o0.y = x0.y + g0.y * y[1]; o0.z = x0.z + g0.z * y[2]; o0.w = x0.w + g0.w * y[3];
            o1.x = x1.x + g1.x * y[4]; o1.y = x1.y + g1.y * y[5]; o1.z = x1.z + g1.z * y[6]; o1.w = x1.w + g1.w * y[7];
            *(float4*)(xo + c) = o0; *(float4*)(xo + c + 4) = o1;
        }
    }
    if (!last) {
        if (nb == NBLK && bid >= OUTPROJ_BUSY0) conv_jobs(P, l, CONV_J1_0 + bid - OUTPROJ_BUSY0, CONV_J2_0, NBLK - OUTPROJ_BUSY0, lds);
        else if (nb != NBLK) conv_jobs(P, l, CONV_J1_0 + bid, CONV_J2_0, nb, lds);
    }
}

#define SPLIT8_BF16(x0, x1, hi, lo) do { u32x4 _h, _l; \
        _Pragma("unroll") for (int _p = 0; _p < 4; ++_p) { \
            const float _a = _p < 2 ? (x0)[2 * _p] : (x1)[2 * _p - 4], _b = _p < 2 ? (x0)[2 * _p + 1] : (x1)[2 * _p - 3]; \
            const u32 _hp = cvt_pk_bf16(_a, _b); \
            _h[_p] = _hp; _l[_p] = cvt_pk_bf16(_a - __uint_as_float(_hp << 16), _b - __uint_as_float(_hp & 0xFFFF0000u)); \
            __builtin_amdgcn_sched_barrier(0); } \
        hi = __builtin_bit_cast(bf16x8, _h); lo = __builtin_bit_cast(bf16x8, _l); } while (0)
DEV void phase_norm2_router(const Params& P, int l, int bid, int nb, char* lds) {
    char* const wsb = opaque_ptr(P.ws);
    const int tidx = opaque_tid();
    const bool last = (l == 1);
    const int ntok = last ? TL : TT;
    const int tpb = ntok / NBLK;
    const int w = tidx >> 6, lane = tidx & 63;
    constexpr int HLS = 1028;
    float* hl = (float*)lds;
    float* part = hl + 16 * HLS;
    int* ents = (int*)(part + 8 * 16 * 64);
    float* modl = (float*)(ents + 1088);
    const float* mod = (const float*)(wsb + OFF_MOD) + (size_t)l * 9 * 6144;
    const float* g = P.in[I_GFFN] + l * D;
    const float* wr = P.in[I_WROUTER] + (size_t)l * D * NEXP;
    const float eb = P.in[I_EBIAS][l * NEXP + lane];
    u16* hb = (u16*)(wsb + OFF_HBUF);
    int* tok_e = (int*)(wsb + OFF_TOKE);
    float* tok_w = (float*)(wsb + OFF_TOKW);
    for (int blk = bid; blk < NBLK; blk += nb) {
        const int t0 = blk * tpb;
        bf16x8 whi[4][4], wlo[4][4];
        {
            const float* qw = wr + (size_t)(w * 128 + 8 * (lane >> 4)) * NEXP + (lane & 15);
#pragma unroll
            for (int ks = 0; ks < 4; ++ks) {
                asm volatile("" : "+v"(qw));
#pragma unroll
                for (int tl4 = 0; tl4 < 4; ++tl4) {
                    const f32x4 f0 = {qw[0 * NEXP + tl4 * 16], qw[1 * NEXP + tl4 * 16], qw[2 * NEXP + tl4 * 16], qw[3 * NEXP + tl4 * 16]};
                    const f32x4 f1 = {qw[4 * NEXP + tl4 * 16], qw[5 * NEXP + tl4 * 16], qw[6 * NEXP + tl4 * 16], qw[7 * NEXP + tl4 * 16]};
                    SPLIT8_BF16(f0, f1, whi[ks][tl4], wlo[ks][tl4]);
                }
                __builtin_amdgcn_sched_barrier(0);
                qw += 32 * NEXP;
            }
        }
        const int mb0 = tok_mb(t0), mb1 = tok_mb(t0 + tpb - 1);
        for (int i = tidx; i < 2048; i += NTHREADS) {
            const int sl = i >> 10, c = i & 1023;
            const float* mrow = mod + (size_t)(sl ? mb1 : mb0) * 6144;
            modl[sl * 2048 + c] = g[c] * (1.f + mrow[4096 + c]);
            modl[sl * 2048 + 1024 + c] = mrow[3072 + c];
        }
        __syncthreads();
        f32x4 xv[2][4];
#pragma unroll
        for (int j = 0; j < 2; ++j) {
            const int tl = 2 * w + j;
            const float* xr = xrow_cur(P, t0 + (tl < tpb ? tl : 0));
#pragma unroll
            for (int i = 0; i < 4; ++i) xv[j][i] = *(const f32x4*)(xr + lane * 4 + i * 256);
        }
        for (int gcur = 0; gcur < tpb + 16; gcur += 16) {
            if (gcur > 0) {
                const int grp = gcur - 16;
            __syncthreads();
            {
                f32x4 accm[4];
#pragma unroll
                for (int tl4 = 0; tl4 < 4; ++tl4) accm[tl4] = (f32x4){0.f, 0.f, 0.f, 0.f};
                const float* hp = hl + (lane & 15) * HLS + w * 128 + 8 * (lane >> 4);
#pragma unroll
                for (int ks = 0; ks < 4; ++ks) {
                    const f32x4 x0 = *(const f32x4*)(hp + ks * 32), x1 = *(const f32x4*)(hp + ks * 32 + 4);
                    bf16x8 ahi, alo;
                    SPLIT8_BF16(x0, x1, ahi, alo);
#pragma unroll
                    for (int tl4 = 0; tl4 < 4; ++tl4) {
                        accm[tl4] = __builtin_amdgcn_mfma_f32_16x16x32_bf16(alo, whi[ks][tl4], accm[tl4], 0, 0, 0);
                        accm[tl4] = __builtin_amdgcn_mfma_f32_16x16x32_bf16(ahi, wlo[ks][tl4], accm[tl4], 0, 0, 0);
                        accm[tl4] = __builtin_amdgcn_mfma_f32_16x16x32_bf16(ahi, whi[ks][tl4], accm[tl4], 0, 0, 0);
                    }
                    __builtin_amdgcn_sched_barrier(0);
                }
#pragma unroll
                for (int tl4 = 0; tl4 < 4; ++tl4)
#pragma unroll
                    for (int r4 = 0; r4 < 4; ++r4) part[(w * 16 + 4 * (lane >> 4) + r4) * 64 + tl4 * 16 + (lane & 15)] = accm[tl4][r4];
            }
            __syncthreads();
#pragma unroll 1
            for (int j = 0; j < 2; ++j) {
                const int tl = 2 * w + j;
                if (grp + tl < tpb) {
                    const int tk = t0 + grp + tl;
                    float a = 0.f;
#pragma unroll
                    for (int ww = 0; ww < 8; ++ww) a += part[(ww * 16 + tl) * 64 + lane];
                    const float sc = sigmoid_f(a);
                    const float bi = sc + eb;
                    const int gbase = lane & ~7;
                    int rk = 0;
#pragma unroll
                    for (int jj = 0; jj < 8; ++jj) { const float o = __shfl(bi, gbase + jj); rk += (o > bi || (o == bi && (gbase + jj) < lane)) ? 1 : 0; }
                    float gs = rk < 2 ? bi : 0.f;
                    gs += __shfl_xor(gs, 1); gs += __shfl_xor(gs, 2); gs += __shfl_xor(gs, 4);
                    const int gi = lane >> 3; int grank = 0;
#pragma unroll
                    for (int jj = 0; jj < 8; ++jj) { const float o = __int_as_float(__builtin_amdgcn_readlane(__float_as_int(gs), jj * 8)); grank += (o > gs || (o == gs && jj < gi)) ? 1 : 0; }
                    const bool gsel = grank < 4;
                    const float val = gsel ? bi : -INFINITY;
                    int erank = 0;
#pragma unroll 8
                    for (int jj = 0; jj < 64; ++jj) { const float o = __int_as_float(__builtin_amdgcn_readlane(__float_as_int(val), jj)); erank += (o > val || (o == val && jj < lane)) ? 1 : 0; }
                    const bool sel = gsel && erank < 8;
                    const float wsum = wave_sum(sel ? sc : 0.f);
                    if (sel) { tok_e[(size_t)tk * 8 + erank] = lane; tok_w[(size_t)tk * 8 + erank] = sc / wsum * 2.5f; ents[(grp + tl) * 8 + erank] = lane; }
                }
            }
                    }
            if (gcur < tpb) {
                const int grp = gcur;
#pragma unroll
            for (int j = 0; j < 2; ++j) {
                const int tl = 2 * w + j;
                const int tk = t0 + grp + tl;
                if (grp + tl < tpb) {
                    const float* ml = modl + (tok_mb(tk) != mb0 ? 2048 : 0);
                    float ss = 0.f;
#pragma unroll
                    for (int i = 0; i < 4; ++i) ss += xv[j][i][0] * xv[j][i][0] + xv[j][i][1] * xv[j][i][1] + xv[j][i][2] * xv[j][i][2] + xv[j][i][3] * xv[j][i][3];
                    ss = wave_sum(ss);
                    const float rinv = rsqrtf(ss * (1.f / 1024.f) + EPS);
#pragma unroll
                    for (int i = 0; i < 4; ++i) {
                        const int c = lane * 4 + i * 256;
                        const float4 gs = *(const float4*)(ml + c);
                        const float4 sh = *(const float4*)(ml + 1024 + c);
                        float4 hv;
                        hv.x = xv[j][i][0] * rinv * gs.x + sh.x; hv.y = xv[j][i][1] * rinv * gs.y + sh.y;
                        hv.z = xv[j][i][2] * rinv * gs.z + sh.z; hv.w = xv[j][i][3] * rinv * gs.w + sh.w;
                        *(float4*)(hl + tl * HLS + c) = hv;
                        uint2 o; o.x = pack2(hv.x, hv.y); o.y = pack2(hv.z, hv.w);
                        *(uint2*)(hb + (size_t)tk * D + c) = o;
                        __builtin_amdgcn_sched_barrier(0);
                    }
                } else {
#pragma unroll
                    for (int i = 0; i < 4; ++i) *(float4*)(hl + tl * HLS + lane * 4 + i * 256) = make_float4(0.f, 0.f, 0.f, 0.f);
                }
            }
#pragma unroll
            for (int j = 0; j < 2; ++j) {
                const int tn = grp + 16 + 2 * w + j;
                const float* xr = xrow_cur(P, t0 + (tn < tpb ? tn : 0));
#pragma unroll
                for (int i = 0; i < 4; ++i) xv[j][i] = *(const f32x4*)(xr + lane * 4 + i * 256);
            }
            }
        }
        __syncthreads();
        {
            int* lpos = (int*)(wsb + OFF_LPOS) + (size_t)blk * tpb * 8;
            int run[8];
#pragma unroll
            for (int ee = 0; ee < 8; ++ee) run[ee] = 0;
            const int nent = tpb * 8;
            const unsigned long long ltmask = (1ull << lane) - 1ull;
            for (int c0 = 0; c0 < nent; c0 += 64) {
                const int idx = c0 + lane;
                const int ej = idx < nent ? ents[idx] : -1;
#pragma unroll
                for (int ee = 0; ee < 8; ++ee) {
                    const int e = w * 8 + ee;
                    const unsigned long long m = __ballot(ej == e);
                    if (ej == e) lpos[idx] = run[ee] + __popcll(m & ltmask);
                    run[ee] += __popcll(m);
                }
            }
            if (lane == 0) {
#pragma unroll
                for (int ee = 0; ee < 8; ++ee) ((int*)(wsb + OFF_CNT))[blk * NEXP + w * 8 + ee] = run[ee];
            }
        }
    }
}

DEV void phase_assign(const Params& P, int l, int bid, int nb, char* lds) {
    char* const wsb = opaque_ptr(P.ws);
    const int tidx = opaque_tid();
    const int ntok = (l == 1) ? TL : TT;
    const int tpb = ntok / NBLK;
    int* s_base = (int*)lds;
    int* s_tot = s_base + 64;
    int* s_n0 = s_tot + 64;
    int* s_off = s_n0 + 64;
    int* s_ub = s_off + 65;
    const int* tok_e = (const int*)(wsb + OFF_TOKE);
    const float* tok_w = (const float*)(wsb + OFF_TOKW);
    const int* lpos = (const int*)(wsb + OFF_LPOS);
    const int* cnt = (const int*)(wsb + OFF_CNT);
    int* rowslot = (int*)(wsb + OFF_ROWSLOT);
    float* rowgate = (float*)(wsb + OFF_ROWGATE);
    int* tile_e = (int*)(wsb + OFF_TILEE);
    int* ulist = (int*)(wsb + OFF_ULIST);
    for (int blk = bid; blk < NBLK; blk += nb) {
        __syncthreads();
        {
            int* s_part = s_ub + 2 * 65;
            const int e = tidx & 63, part = tidx >> 6;
            int base = 0, tot = 0, n0 = 0;
#pragma unroll 8
            for (int b2 = part * 32; b2 < part * 32 + 32; ++b2) { const int c = cnt[b2 * NEXP + e]; if (b2 < blk) base += c; if (b2 < NBLK / NPASS) n0 += c; tot += c; }
            s_part[(part * 3 + 0) * 64 + e] = base; s_part[(part * 3 + 1) * 64 + e] = tot; s_part[(part * 3 + 2) * 64 + e] = n0;
            __syncthreads();
            if (tidx < NEXP) {
                int b_ = 0, t_ = 0, n_ = 0;
#pragma unroll
                for (int p2 = 0; p2 < 8; ++p2) { b_ += s_part[(p2 * 3 + 0) * 64 + tidx]; t_ += s_part[(p2 * 3 + 1) * 64 + tidx]; n_ += s_part[(p2 * 3 + 2) * 64 + tidx]; }
                s_base[tidx] = b_; s_tot[tidx] = t_; s_n0[tidx] = n_;
            }
        }
        __syncthreads();
        if (tidx == 0) { int run = 0; for (int e = 0; e < NEXP; ++e) { s_off[e] = run; run += (s_tot[e] + 255) & ~255; } s_off[NEXP] = run; }
        __syncthreads();
        for (int i = tidx; i < tpb * 8; i += NTHREADS) {
            const size_t gi = (size_t)blk * tpb * 8 + i;
            const int e = tok_e[gi];
            const int pos = s_off[e] + s_base[e] + lpos[gi];
            const int tk = blk * tpb + (i >> 3);
            rowslot[pos] = tk * 9 + (i & 7);
            rowgate[pos] = tok_w[gi];
        }
        if (blk < NEXP) {
            const int e = blk;
            const int p0 = s_off[e] + s_tot[e], p1 = s_off[e + 1];
            for (int p = p0 + tidx; p < p1; p += NTHREADS) { rowslot[p] = -1; rowgate[p] = 0.f; }
        }
        if (blk == 0) {
            if (tidx < NEXP) { const int e = tidx; for (int tl = s_off[e] >> 8; tl < (s_off[e + 1] >> 8); ++tl) tile_e[tl] = e; }
            if (tidx == 0) tile_e[1279] = s_off[NEXP] >> 8;
            __syncthreads();
            if (tidx < 2) {
                const int h = tidx; int run = 0;
                for (int e = 0; e < NEXP; ++e) {
                    const int lo = s_off[e] + (h ? s_n0[e] : 0), hi = s_off[e] + (h ? s_tot[e] : s_n0[e]);
                    s_ub[h * 65 + e] = run;
                    if (hi > lo) run += ((hi - 1) >> 8) - (lo >> 8) + 1;
                }
                s_ub[h * 65 + NEXP] = run;
                ulist[h * 1536 + 1535] = run;
            }
            __syncthreads();
            if (tidx < 128) {
                const int h = tidx >> 6, e = tidx & 63;
                const int lo = s_off[e] + (h ? s_n0[e] : 0), hi = s_off[e] + (h ? s_tot[e] : s_n0[e]);
                if (hi > lo) { int o = s_ub[h * 65 + e]; for (int uu = lo >> 8; uu <= ((hi - 1) >> 8); ++uu) ulist[h * 1536 + o++] = uu; }
            }
        }
    }
}

DEV void phase_gemm1(const Params& P, int l, int bid, int nb, char* lds) {
    char* const wsb = opaque_ptr(P.ws);
    const int ntok = (l == 1) ? TL : TT;
    const int* tile_e = (const int*)(wsb + OFF_TILEE);
    const int nrt = tile_e[1279];
    const int nst = ntok / 256;
    const int* rowslot = (const int*)(wsb + OFF_ROWSLOT);
    const u16* A = (const u16*)(wsb + OFF_HBUF);
    const int nun = (nrt + nst) * 2, per8 = (nun + 7) >> 3;
    const int ubase = (bid & 7) * per8, ustep = nb >> 3;
    const float* rowgate = (const float*)(wsb + OFF_ROWGATE);
    auto setup = [&](int i, GemmPre& g, u16*& dst, const float*& gp) {
        const int mt = i >> 1, nt_ = i & 1;
        gp = (mt < nrt) ? rowgate + mt * 256 : nullptr;
        if (mt < nrt) {
            const int e = tile_e[mt];
            const int* rs = rowslot + mt * 256;
            gemm_pre_make(g, A, [=](int r) -> u32 { const int sl = rs[r]; return (u32)(sl < 0 ? 0 : sl / 9) * D; }, (const u16*)(wsb + OFF_W1) + ((size_t)e * 512 + nt_ * 256) * D, D);
            dst = (u16*)(wsb + OFF_ACT) + (size_t)mt * 256 * 256 + nt_ * 128;
        } else {
            const int row0 = (mt - nrt) * 256;
            gemm_pre_make(g, A, [=](int r) -> u32 { return (u32)(row0 + r) * D; }, (const u16*)(wsb + OFF_WSH1) + ((size_t)l * 512 + nt_ * 256) * D, D);
            dst = (u16*)(wsb + OFF_ACTSH) + (size_t)row0 * 256 + nt_ * 128;
        }
    };
    int uu = bid >> 3;
    GemmPre cur; u16* cdst = nullptr; const float* cgp = nullptr;
    bool have = (uu < per8) && (ubase + uu < nun);
    if (have) { setup(ubase + uu, cur, cdst, cgp); __syncthreads(); gemm_pre_issue(cur, lds); }
    while (have) {
        const int un = uu + ustep;
        const bool have_n = (un < per8) && (ubase + un < nun);
        GemmPre nxt; u16* ndst = nullptr; const float* ngp = nullptr;
        if (have_n) setup(ubase + un, nxt, ndst, ngp);
        u16* const dst = cdst; const float* const gp = cgp;
        gemm_tile_pipe(cur, lds,
            [&]() { if (have_n) gemm_pre_issue(nxt, lds); },
            [&](f32x4 (&acc)[2][2][4][2], int wr, int wc, int fr, int fq) {
#pragma unroll
                for (int ai = 0; ai < 2; ++ai)
#pragma unroll
                    for (int m = 0; m < 4; ++m) {
                        const float gsc = gp ? gp[ai * HALF + wr * 64 + m * 16 + fr] * 32.f : 1.f;
#pragma unroll
                        for (int n = 0; n < 2; ++n) {
                            float o[4];
#pragma unroll
                            for (int jj = 0; jj < 4; ++jj) o[jj] = silu_f(acc[ai][0][m][n][jj]) * acc[ai][1][m][n][jj] * gsc;
                            uint2 pk; pk.x = cvt_pk_bf16(o[0], o[1]); pk.y = cvt_pk_bf16(o[2], o[3]);
                            *(uint2*)(dst + (size_t)(ai * HALF + wr * 64 + m * 16 + fr) * 256 + wc * 32 + n * 16 + fq * 4) = pk;
                        }
                    }
            });
        cur = nxt; cdst = ndst; cgp = ngp; uu = un; have = have_n;
    }
}

DEV void phase_gemm2(const Params& P, int l, int hx, int bid, int nb, char* lds) {
    char* const wsb = opaque_ptr(P.ws);
    const int ntok = (l == 1) ? TL : TT;
    const int nhalf = ntok / NPASS;
    const int* tile_e = (const int*)(wsb + OFF_TILEE);
    const int* ulist = (const int*)(wsb + OFF_ULIST) + hx * 1536;
    const int n_ru = ulist[1535];
    const int nst = nhalf / 256;
    const int* rowslot = (const int*)(wsb + OFF_ROWSLOT);
    unsigned char* yk = (unsigned char*)(wsb + OFF_YK);
#define G2_WAIT(n) asm volatile("s_waitcnt vmcnt(" #n ")" ::: "memory")
    const int nun = n_ru + nst, per8 = (nun + 7) >> 3;
    const int xu0 = (bid & 7) * per8;
    int nux = nun - xu0; if (nux > per8) nux = per8;
    if (nux <= 0) return;
    const int nbx = nb >> 3, jx = bid >> 3;
    const int P0 = (int)(((long long)8 * nux * jx) / nbx), P1 = (int)(((long long)8 * nux * (jx + 1)) / nbx);
    if (P1 <= P0) return;
    const int uk0 = P0 >> 3;
    const int nk = ((P1 - 1) >> 3) - uk0 + 1;
    const int G0 = P0 * 2, G1 = P1 * 2;
    const int tidx = opaque_tid();
    const int w = tidx >> 6, lane = tidx & 63, fr = lane & 15, fq = lane >> 4, wr = w >> 1, wc = w & 1;
    const int prow = tidx >> 5, pch = tidx & 31;
    const u16* const W2b = (const u16*)(wsb + OFF_W2);
    const u16* const WSb = (const u16*)(wsb + OFF_WSH2) + (size_t)l * D * 256;
    int* const s_u = (int*)(lds + 4 * 32768);
    __syncthreads();
    if (tidx < 16 && tidx < nk) {
        const int u = xu0 + uk0 + tidx;
        if (u < n_ru) { const int t = ulist[u]; s_u[2 * tidx] = t; s_u[2 * tidx + 1] = tile_e[t]; }
        else { s_u[2 * tidx] = -1 - (u - n_ru); s_u[2 * tidx + 1] = 64; }
    }
    __syncthreads();
#define G2_UNIT_E(k) __builtin_amdgcn_readfirstlane(s_u[2 * (k) + 1])
#define G2_UNIT_BT(k) (G2_UNIT_E(k) < 64 ? W2b + (size_t)G2_UNIT_E(k) * D * 256 : WSb)
    const u16* BtL = G2_UNIT_BT(0);
#define G2_ISSUE(gi) do { const int _c = (gi) & 15; \
        const u16* _s0 = BtL + (size_t)((_c >> 1) * 128 + (prow >> 2) * 16 + (_c & 1) * 8 + (prow & 3)) * 256 + ((pch ^ prow) * 8); \
        _Pragma("unroll") for (int ps = 0; ps < 4; ++ps) \
            __builtin_amdgcn_global_load_lds((const unsigned*)(_s0 + (size_t)((ps >> 1) * 64 + (ps & 1) * 4) * 256), \
                (LAS unsigned*)((LAS char*)lds + ((gi) & 3) * 32768 + ps * 8192 + tidx * 16), 16, 0, 0); } while (0)
#define G2_ISSUE_AT(ga) do { if ((((ga) & 15) == 0) || (ga) == G0) BtL = G2_UNIT_BT(((ga) >> 4) - uk0); G2_ISSUE(ga); } while (0)
    G2_ISSUE_AT(G0); if (G0 + 1 < G1) G2_ISSUE_AT(G0 + 1); if (G0 + 2 < G1) G2_ISSUE_AT(G0 + 2);
    bf16x8 af[4][8];
    u32 yo[4];
    bool routed = true;
#define G2_UNIT_SETUP(k) do { \
        const int ut = __builtin_amdgcn_readfirstlane(s_u[2 * (k)]); \
        routed = ut >= 0; \
        const int su = -1 - ut;                         \
        const u16* A; int urow; \
        if (routed) { urow = ut * 256; A = (const u16*)(wsb + OFF_ACT) + (size_t)urow * 256; } \
        else { urow = hx * nhalf + su * 256; A = (const u16*)(wsb + OFF_ACTSH) + (size_t)urow * 256; } \
        const u16* ap = A + (size_t)(wr * 64 + fr) * 256 + fq * 8; \
        _Pragma("unroll") for (int m = 0; m < 4; ++m) _Pragma("unroll") for (int ks = 0; ks < 8; ++ks) \
            af[m][ks] = *reinterpret_cast<const bf16x8*>(ap + m * 16 * 256 + ks * 32); \
        _Pragma("unroll") for (int m = 0; m < 4; ++m) { \
            const int R = wr * 64 + m * 16 + fr; int slot; \
            if (routed) { const int sl = rowslot[urow + R]; const int ls = sl - hx * nhalf * 9; \
                slot = (sl < 0 || ls < 0 || ls >= nhalf * 9) ? nhalf * 9 : ls; }     \
            else slot = (su * 256 + R) * 9 + 8; \
              \
            const int tl9 = slot / 9, k9 = slot - tl9 * 9; \
            yo[m] = (u32)tl9 * 10240u + (u32)k9 * 1024u + (u32)(routed ? (wc * 64 + fq * 16) : (wc * 64 + fq * 16) * 2); } \
          \
        asm volatile("" :: "v"(af[0][0]), "v"(af[0][1]), "v"(af[0][2]), "v"(af[0][3]), "v"(af[0][4]), "v"(af[0][5]), "v"(af[0][6]), "v"(af[0][7]), \
                           "v"(af[1][0]), "v"(af[1][1]), "v"(af[1][2]), "v"(af[1][3]), "v"(af[1][4]), "v"(af[1][5]), "v"(af[1][6]), "v"(af[1][7])); \
        asm volatile("" :: "v"(af[2][0]), "v"(af[2][1]), "v"(af[2][2]), "v"(af[2][3]), "v"(af[2][4]), "v"(af[2][5]), "v"(af[2][6]), "v"(af[2][7]), \
                           "v"(af[3][0]), "v"(af[3][1]), "v"(af[3][2]), "v"(af[3][3]), "v"(af[3][4]), "v"(af[3][5]), "v"(af[3][6]), "v"(af[3][7])); } while (0)
#define G2_BREAD(dst, gi, n, kh) do { const char* _bb = lds + ((gi) & 3) * 32768 + (wc * 32 + (n) * 16 + fr) * 512; \
        _Pragma("unroll") for (int k4 = 0; k4 < 4; ++k4) dst[k4] = *reinterpret_cast<const bf16x8*>(_bb + (((((kh) * 4 + k4) * 4 + fq) ^ fr) * 16)); } while (0)
#define G2_MMA(accv, bv, kh) do { _Pragma("unroll") for (int k4 = 0; k4 < 4; ++k4) _Pragma("unroll") for (int m = 0; m < 4; ++m) \
        accv[m] = __builtin_amdgcn_mfma_f32_16x16x32_bf16(bv[k4], af[m][(kh) * 4 + k4], accv[m], 0, 0, 0); } while (0)
    G2_UNIT_SETUP(0);
    G2_WAIT(0);
    __builtin_amdgcn_s_barrier();
    if (G0 + 3 < G1) G2_ISSUE_AT(G0 + 3);
    bf16x8 bX[4], bY[4];
    G2_BREAD(bX, G0, 0, 0);
#define G2_PK8(dst, accv) do { \
        const float v0 = __builtin_amdgcn_fmed3f(accv[0], -440.f, 440.f), v1 = __builtin_amdgcn_fmed3f(accv[1], -440.f, 440.f); \
        const float v2 = __builtin_amdgcn_fmed3f(accv[2], -440.f, 440.f), v3 = __builtin_amdgcn_fmed3f(accv[3], -440.f, 440.f); \
        int pk = __builtin_amdgcn_cvt_pk_fp8_f32(v0, v1, 0, false); \
        pk = __builtin_amdgcn_cvt_pk_fp8_f32(v2, v3, pk, true); dst = (u32)pk; } while (0)
#pragma unroll 1
    for (int gp = P0; gp < P1; ++gp) {
        const int p = gp & 7;
        u32 pkq[4][4];
#pragma unroll
        for (int ci = 0; ci < 2; ++ci) {
            const int g = gp * 2 + ci;
            u32 sh[4][2];
            {
                f32x4 acc0[4] = {};
                __builtin_amdgcn_s_waitcnt(0xC07F);
                G2_BREAD(bY, g, 0, 1);
                __builtin_amdgcn_sched_barrier(0);
                G2_MMA(acc0, bX, 0);
                __builtin_amdgcn_sched_barrier(0);
                G2_BREAD(bX, g, 1, 0);
                __builtin_amdgcn_s_waitcnt(0xC47F);
                asm volatile("s_nop 0");
                __builtin_amdgcn_sched_barrier(0);
                G2_MMA(acc0, bY, 1);
                __builtin_amdgcn_sched_barrier(0);
                if (routed) {
#pragma unroll
                    for (int m = 0; m < 4; ++m) G2_PK8(pkq[m][ci * 2], acc0[m]);
                } else {
#pragma unroll
                    for (int m = 0; m < 4; ++m) { sh[m][0] = cvt_pk_bf16(acc0[m][0], acc0[m][1]); sh[m][1] = cvt_pk_bf16(acc0[m][2], acc0[m][3]); }
                }
                __builtin_amdgcn_sched_barrier(0);
            }
            f32x4 acc1[4] = {};
            __builtin_amdgcn_s_waitcnt(0xC07F);
            G2_BREAD(bY, g, 1, 1);
            __builtin_amdgcn_sched_barrier(0);
            G2_MMA(acc1, bX, 0);
            __builtin_amdgcn_sched_barrier(0);
            __builtin_amdgcn_s_waitcnt(0xC07F);
            asm volatile("s_nop 0");
            if (g + 1 < G1) {
                if (g + 3 >= G1) G2_WAIT(0);
                else if (ci == 0 && g >= G0 + 4) G2_WAIT(16);
                else G2_WAIT(12);
                asm volatile("s_waitcnt lgkmcnt(0)" ::: "memory");
                __builtin_amdgcn_s_barrier();
                if (g + 4 < G1) G2_ISSUE_AT(g + 4);
                G2_BREAD(bX, g + 1, 0, 0);
                __builtin_amdgcn_sched_barrier(0);
            }
            G2_MMA(acc1, bY, 1);
            __builtin_amdgcn_sched_barrier(0);
            if (!routed) {
#pragma unroll
                for (int m = 0; m < 4; ++m) {
                    u32x4 s0 = {sh[m][0], sh[m][1], cvt_pk_bf16(acc1[m][0], acc1[m][1]), cvt_pk_bf16(acc1[m][2], acc1[m][3])};
                    *(u32x4*)(yk + yo[m] + p * 256 + ci * 16) = s0;
                }
            } else {
#pragma unroll
                for (int m = 0; m < 4; ++m) G2_PK8(pkq[m][ci * 2 + 1], acc1[m]);
            }
        }
        if (routed) {
#pragma unroll
            for (int m = 0; m < 4; ++m) {
                u32x4 s0 = {pkq[m][0], pkq[m][1], pkq[m][2], pkq[m][3]};
                *(u32x4*)(yk + yo[m] + p * 128) = s0;
            }
        }
        if (p == 7 && gp + 1 < P1) G2_UNIT_SETUP(((gp + 1) >> 3) - uk0);
    }
#undef G2_UNIT_SETUP
#undef G2_PK8
#undef G2_BREAD
#undef G2_MMA
    asm volatile("s_waitcnt lgkmcnt(0)" ::: "memory");
    __builtin_amdgcn_s_barrier();
#undef G2_ISSUE
#undef G2_ISSUE_AT
#undef G2_UNIT_BT
#undef G2_UNIT_E
#undef G2_WAIT
}

DEV void phase_combine(const Params& P, int l, int hx, int bid, int nb) {
    char* const wsb = opaque_ptr(P.ws);
    const int tidx = opaque_tid();
    const int ntok = (l == 1) ? TL : TT;
    const int nhalf = ntok / NPASS;
    const float* mod = (const float*)(wsb + OFF_MOD) + (size_t)l * 9 * 6144;
    const u16* yk = (const u16*)(wsb + OFF_YK);
    const int sub = tidx & 127;
    for (int tl = bid * 4 + (tidx >> 7); tl < nhalf; tl += nb * 4) {
        const int tk = hx * nhalf + tl;
        float acc[8];
#pragma unroll
        for (int j = 0; j < 8; ++j) acc[j] = 0.f;
#if YK_FP8
        typedef float f2v __attribute__((ext_vector_type(2)));
#pragma unroll
        for (int k = 0; k < 8; ++k) {
            const uint2 q = *(const uint2*)((const unsigned char*)yk + (size_t)tl * 10240 + k * 1024 + sub * 8);
            const f2v a0 = __builtin_amdgcn_cvt_pk_f32_fp8((int)q.x, false), a1 = __builtin_amdgcn_cvt_pk_f32_fp8((int)q.x, true);
            const f2v a2 = __builtin_amdgcn_cvt_pk_f32_fp8((int)q.y, false), a3 = __builtin_amdgcn_cvt_pk_f32_fp8((int)q.y, true);
            acc[0] += a0[0]; acc[1] += a0[1]; acc[2] += a1[0]; acc[3] += a1[1];
            acc[4] += a2[0]; acc[5] += a2[1]; acc[6] += a3[0]; acc[7] += a3[1];
        }
        {
            float ys[8]; unpack8(*(const uint4*)((const unsigned char*)yk + (size_t)tl * 10240 + 8192 + sub * 16), ys);
#pragma unroll
            for (int j = 0; j < 8; ++j) acc[j] = acc[j] * (1.f / 32.f) + ys[j];
        }
#else
#pragma unroll
        for (int k = 0; k < 9; ++k) {
            float y[8]; unpack8(*(const uint4*)(yk + ((size_t)tl * 9 + k) * D + sub * 8), y);
#pragma unroll
            for (int j = 0; j < 8; ++j) acc[j] += y[j];
        }
#endif
        float* xr = xrow_cur(P, tk) + sub * 8;
        const float* gt = mod + (size_t)tok_mb(tk) * 6144 + 5120 + sub * 8;
        float4 x0 = *(const float4*)xr, x1 = *(const float4*)(xr + 4);
        const float4 g0 = *(const float4*)gt, g1 = *(const float4*)(gt + 4);
        x0.x += g0.x * acc[0]; x0.y += g0.y * acc[1]; x0.z += g0.z * acc[2]; x0.w += g0.w * acc[3];
        x1.x += g1.x * acc[4]; x1.y += g1.y * acc[5]; x1.z += g1.z * acc[6]; x1.w += g1.w * acc[7];
        *(float4*)xr = x0; *(float4*)(xr + 4) = x1;
    }
}

typedef __attribute__((address_space(4))) const char k4char;
DEV const Params& kparams() {
    k4char* p = (k4char*)__builtin_amdgcn_kernarg_segment_ptr();
    asm volatile("" : "+s"(p));
    return *(const Params*)p;
}
enum { PH_INIT = 0, PH_PREP, PH_INPROJ, PH_ATTNA, PH_ATTNN, PH_S5SCAN, PH_S5READ, PH_OUTPROJ, PH_NORM2, PH_COUNT, PH_ASSIGN, PH_GEMM1, PH_GEMM2, PH_COMBINE, PH_POISON };

template <int PH>
__global__ void __launch_bounds__(NTHREADS, 2) k_phase(Params P) {
    extern __shared__ __attribute__((aligned(16))) char lds[];
    const int bid = blockIdx.x, nb = gridDim.x, l = P.layer, q = P.sub;
    (void)l; (void)q; (void)lds;
#if !ONE_LAUNCH
    if (PH == PH_INIT) phase_init(P, bid, nb, lds);
    if (PH == PH_PREP) phase_prep(P, l, bid, nb, lds);
    if (PH == PH_INPROJ) phase_inproj(P, l, bid, nb, lds);
#if NAIVE_ATTN
    if (PH == PH_ATTNA) phase_attnA_naive(P, l, bid, nb);
    if (PH == PH_ATTNN) phase_attnN_naive(P, l, bid, nb);
#else
    if (PH == PH_ATTNA) phase_attnA(P, l, bid, nb, lds);
    if (PH == PH_ATTNN) phase_attnN(P, l, bid, nb, lds);
#endif
#if NAIVE_S5
    if (PH == PH_S5SCAN) phase_s5_scan_naive(P, l, bid, nb);
    if (PH == PH_S5READ) phase_s5_readout_naive(P, l, bid, nb, lds);
#endif
    if (PH == PH_OUTPROJ) phase_outproj(P, l, bid, nb, lds);
    if (PH == PH_NORM2) phase_norm2_router(P, l, bid, nb, lds);
    if (PH == PH_ASSIGN) phase_assign(P, l, bid, nb, lds);
    if (PH == PH_GEMM1) phase_gemm1(P, l, bid, nb, lds);
    if (PH == PH_GEMM2) phase_gemm2(P, l, q, bid, nb, lds);
    if (PH == PH_COMBINE) phase_combine(P, l, q, bid, nb);
#endif
    if (PH == PH_POISON) { for (size_t i = (size_t)bid * NTHREADS + threadIdx.x; i < (size_t)TL * D; i += (size_t)nb * NTHREADS) P.out[i] = __uint_as_float(0x7FC00000u); }
}


#if ONE_LAUNCH
__global__ void __launch_bounds__(NTHREADS, 2) k_mega(Params Pin) {
    extern __shared__ __attribute__((aligned(16))) char lds[];
    if (threadIdx.x == 0) *(uint4*)(lds + LDS_BYTES - 16) = make_uint4(0u, 0u, 0u, 0u);
    if ((threadIdx.x & 63) == 0) ((volatile LAS unsigned char*)(LAS char*)lds)[LDS_TID_TABLE + hw_wave_slot()] = (unsigned char)(threadIdx.x >> 6);
    __syncthreads();
    XcdBarrier bar = xcd_barrier_post((unsigned*)(kparams().ws + OFF_BAR), (volatile LAS unsigned*)(LAS char*)(lds + LDS_BYTES - 16));
    phase_init(kparams(), opaque_s((int)blockIdx.x), opaque_s((int)gridDim.x), lds);
    s5_kf_init(kparams(), opaque_s((int)blockIdx.x), opaque_s((int)gridDim.x), lds);
    xcd_barrier(bar);
#define RUN(id, stmt) do { stmt; if (REPEAT_PH == (id)) { xcd_barrier(bar); stmt; } } while (0)
    for (int l = 0; l < 2; ++l) {
        RUN(1, { phase_prep(kparams(), l, opaque_s((int)blockIdx.x), opaque_s((int)gridDim.x), lds); s5_gen(kparams(), l, opaque_s((int)blockIdx.x), opaque_s((int)gridDim.x), lds); });
        xcd_barrier(bar);
        RUN(2, phase_inproj(kparams(), l, opaque_s((int)blockIdx.x), opaque_s((int)gridDim.x), lds));
        xcd_barrier(bar);
        RUN(3, { phase_s5_E(kparams(), l, opaque_s((int)blockIdx.x), opaque_s((int)gridDim.x), lds); phase_attnN(kparams(), l, opaque_s((int)blockIdx.x), opaque_s((int)gridDim.x), lds); });
        xcd_barrier(bar);
        RUN(4, phase_s5_carry(kparams(), l, opaque_s((int)blockIdx.x), opaque_s((int)gridDim.x)));
        xcd_barrier(bar);
        RUN(5, phase_s5_Y(kparams(), l, opaque_s((int)blockIdx.x), opaque_s((int)gridDim.x), lds));
        xcd_barrier(bar);
        RUN(6, { phase_s5_glu(kparams(), l, opaque_s((int)blockIdx.x), opaque_s((int)gridDim.x), lds); phase_attnA(kparams(), l, opaque_s((int)blockIdx.x), opaque_s((int)gridDim.x), lds); });
        xcd_barrier(bar);
        phase_outproj(kparams(), l, opaque_s((int)blockIdx.x), opaque_s((int)gridDim.x), lds);
        xcd_barrier(bar);
        RUN(8, phase_norm2_router(kparams(), l, opaque_s((int)blockIdx.x), opaque_s((int)gridDim.x), lds));
        xcd_barrier(bar);
        RUN(10, phase_assign(kparams(), l, opaque_s((int)blockIdx.x), opaque_s((int)gridDim.x), lds));
        xcd_barrier(bar);
        RUN(11, phase_gemm1(kparams(), l, opaque_s((int)blockIdx.x), opaque_s((int)gridDim.x), lds));
        xcd_barrier(bar);
        for (int hx = 0; hx < NPASS; ++hx) {
            RUN(12, phase_gemm2(kparams(), l, hx, opaque_s((int)blockIdx.x), opaque_s((int)gridDim.x), lds));
            xcd_barrier(bar);
            phase_combine(kparams(), l, hx, opaque_s((int)blockIdx.x), opaque_s((int)gridDim.x));
            xcd_barrier(bar);
        }
    }
}
#endif

template <int PH>
static void launch_phase(Params& P, int l, int q, hipStream_t stream) {
    static bool attr_done = false;
    if (!attr_done) { (void)hipFuncSetAttribute((const void*)k_phase<PH>, hipFuncAttributeMaxDynamicSharedMemorySize, LDS_BYTES); attr_done = true; }
    P.layer = l; P.sub = q;
    hipLaunchKernelGGL(k_phase<PH>, dim3(NBLK), dim3(NTHREADS), LDS_BYTES, stream, P);
}

extern "C" void kernel_launch(void* const* d_in, const int* in_sizes, int n_in, void* d_out, int out_size, void* d_ws, size_t ws_size, hipStream_t stream) {
    Params P;
    memset(&P, 0, sizeof(P));
    for (int i = 0; i < 35; ++i) P.in[i] = (const float*)d_in[i];
    P.out = (float*)d_out; P.ws = (char*)d_ws;
    if (n_in != 35 || ws_size < WS_NEED) {
        fprintf(stderr, "kernel_launch: need %zu bytes of workspace, got %zu (n_in %d)\n", (size_t)WS_NEED, ws_size, n_in);
        launch_phase<PH_POISON>(P, 0, 0, stream);
        return;
    }
    (void)hipMemsetAsync(d_ws, 0, 16384, stream);
#if ONE_LAUNCH
    {
        static bool attr_done = false;
        if (!attr_done) { (void)hipFuncSetAttribute((const void*)k_mega, hipFuncAttributeMaxDynamicSharedMemorySize, LDS_BYTES); attr_done = true; }
        hipLaunchKernelGGL(k_mega, dim3(NBLK), dim3(NTHREADS), LDS_BYTES, stream, P);
        return;
    }
#endif
#if !ONE_LAUNCH
    launch_phase<PH_INIT>(P, 0, 0, stream);
    for (int l = 0; l < 2; ++l) {
        launch_phase<PH_PREP>(P, l, 0, stream);
        launch_phase<PH_INPROJ>(P, l, 0, stream);
        launch_phase<PH_ATTNA>(P, l, 0, stream);
        launch_phase<PH_ATTNN>(P, l, 0, stream);
        launch_phase<PH_S5SCAN>(P, l, 0, stream);
        launch_phase<PH_S5READ>(P, l, 0, stream);
        launch_phase<PH_OUTPROJ>(P, l, 0, stream);
        launch_phase<PH_NORM2>(P, l, 0, stream);
        launch_phase<PH_COUNT>(P, l, 0, stream);
        launch_phase<PH_ASSIGN>(P, l, 0, stream);
        launch_phase<PH_GEMM1>(P, l, 0, stream);
        for (int q = 0; q < 4; ++q) {
            launch_phase<PH_GEMM2>(P, l, q, stream);
            launch_phase<PH_COMBINE>(P, l, q, stream);
        }
    }
#endif
}
```

```cpp
#include <hip/hip_runtime.h>
#include <stdint.h>
#include <stdio.h>
#include <string.h>

#ifndef ONE_LAUNCH
#define ONE_LAUNCH 1
#endif
#ifndef REPEAT_PH
#define REPEAT_PH 0
#endif
#ifndef YK_FP8
#define YK_FP8 1
#endif
#ifndef NAIVE_GEMM
#define NAIVE_GEMM 0
#endif
#ifndef NAIVE_ATTN
#define NAIVE_ATTN 0
#endif
#ifndef NAIVE_S5
#define NAIVE_S5 0
#endif

#define DEV __device__ __forceinline__
typedef unsigned short u16;
typedef unsigned int u32;
using bf16x8 = __attribute__((ext_vector_type(8))) short;
using f32x4 = __attribute__((ext_vector_type(4))) float;
using f32x16 = __attribute__((ext_vector_type(16))) float;
using u32x4 = __attribute__((ext_vector_type(4))) unsigned;
#define LAS __attribute__((address_space(3)))

constexpr int D = 1024, NBATCH = 8, SEQ = 4096, LCTX = 256;
constexpr int TL = NBATCH * SEQ;
constexpr int TC = NBATCH * LCTX;
constexpr int TT = TL + TC;
constexpr int INC = 2560;
constexpr int NKEY = SEQ + LCTX;
constexpr int NEXP = 64;
constexpr int NTHREADS = 512;
constexpr int NBLK = 256;
constexpr int MAXROWS = TT * 8 + NEXP * 256;
constexpr int NPASS = 1;
constexpr int THALF = TT / NPASS;
constexpr float EPS = 1e-6f;
constexpr float LOG2E = 1.4426950408889634f;

constexpr size_t al(size_t x) { return (x + 255) & ~(size_t)255; }
constexpr size_t OFF_BAR = 0;
constexpr size_t OFF_MOD = OFF_BAR + 16384;
constexpr size_t OFF_ROPE = OFF_MOD + al(2 * 9 * 6144 * 4);
constexpr size_t OFF_MISC = OFF_ROPE + al(2 * 64 * 8 * 4);
constexpr size_t OFF_CNT = OFF_MISC + 4096;
constexpr size_t OFF_TILEE = OFF_CNT + al(256 * 64 * 4);
constexpr size_t OFF_ULIST = OFF_TILEE + al(1280 * 4);
constexpr size_t OFF_TOKE = OFF_ULIST + al(2 * 1536 * 4);
constexpr size_t OFF_TOKW = OFF_TOKE + al((size_t)TT * 8 * 4);
constexpr size_t OFF_LPOS = OFF_TOKW + al((size_t)TT * 8 * 4);
constexpr size_t OFF_ROWSLOT = OFF_LPOS + al((size_t)TT * 8 * 4);
constexpr size_t OFF_ROWGATE = OFF_ROWSLOT + al((size_t)MAXROWS * 4);
constexpr size_t OFF_KF = OFF_ROWGATE + al((size_t)MAXROWS * 4);
constexpr size_t OFF_WIN = OFF_KF + al((size_t)2 * 16 * 2 * 32 * 256 * 4);
constexpr size_t OFF_WOUT = OFF_WIN + al((size_t)2 * INC * D * 2);
constexpr size_t OFF_WGLU = OFF_WOUT + al((size_t)2 * D * D * 2);
constexpr size_t OFF_WSH1 = OFF_WGLU + al((size_t)2 * 256 * 256 * 2);
constexpr size_t OFF_WSH2 = OFF_WSH1 + al((size_t)2 * 512 * D * 2);
constexpr size_t OFF_CTXS = OFF_WSH2 + al((size_t)2 * D * 256 * 2);
constexpr size_t OFF_W2 = OFF_CTXS + al((size_t)TC * D * 4);
constexpr size_t OFF_W1 = OFF_W2 + al((size_t)NEXP * D * 256 * 2);
constexpr size_t OFF_HBUF = OFF_W1 + al((size_t)NEXP * 512 * D * 2);
constexpr size_t OFF_M1 = OFF_HBUF + al((size_t)TT * D * 2);
constexpr size_t OFF_M3 = OFF_M1 + al((size_t)16 * 256 * 512 * 2);
constexpr size_t OFF_R = OFF_M3 + al((size_t)16 * 512 * 768 * 2);
constexpr size_t OFF_QA = OFF_R;
constexpr size_t OFF_QAC = OFF_QA + al((size_t)NBATCH * 6 * 2 * SEQ * 32 * 2);
constexpr size_t OFF_KA = OFF_QAC + al((size_t)NBATCH * 6 * 2 * LCTX * 32 * 2);
constexpr size_t OFF_VAT = OFF_KA + al((size_t)NBATCH * 6 * NKEY * 64 * 2);
constexpr size_t OFF_QN = OFF_VAT + al((size_t)NBATCH * 6 * NKEY * 64 * 2);
constexpr size_t OFF_QNC = OFF_QN + al((size_t)NBATCH * 6 * SEQ * 64 * 2);
constexpr size_t OFF_KN = OFF_QNC + al((size_t)NBATCH * 6 * LCTX * 64 * 2);
constexpr size_t OFF_VNT = OFF_KN + al((size_t)NBATCH * 6 * NKEY * 64 * 2);
constexpr size_t OFF_U = OFF_VNT + al((size_t)NBATCH * 6 * NKEY * 64 * 2);
constexpr size_t OFF_XS5 = OFF_U + al((size_t)TT * 256 * 2);
constexpr size_t OFF_ES5 = OFF_XS5 + al((size_t)16 * 1088 * 768 * 2);
constexpr size_t OFF_GBUF = OFF_ES5 + al((size_t)16 * 1088 * 256 * 2);
constexpr size_t OFF_MIXEND = OFF_GBUF + al((size_t)TT * 256 * 2);
constexpr size_t OFF_YK = OFF_W1;
constexpr size_t OFF_ACT = OFF_YK + al((size_t)(THALF + 1) * 10240);
constexpr size_t OFF_ACTSH = OFF_ACT + al((size_t)MAXROWS * 256 * 2);
constexpr size_t OFF_MOEEND = OFF_ACTSH + al((size_t)TT * 256 * 2);
constexpr size_t WS_NEED = OFF_MIXEND > OFF_MOEEND ? OFF_MIXEND : OFF_MOEEND;

constexpr int LDS_BYTES = 160 * 1024;
constexpr int CS_STRIDE = 264;

struct Params {
    const float* in[35];
    float* out;
    char* ws;
    int layer;
    int sub;
};

enum { I_X = 0, I_C, I_CTX, I_CCTX, I_WMOD, I_BMOD, I_GMIX, I_GFFN, I_WIN, I_WOUT, I_AGQ, I_AGK, I_ALAM, I_AGSUB, I_NGQ, I_NGK, I_NRPB,
       I_S5ARE, I_S5AIM, I_S5LDT, I_S5BRE, I_S5BIM, I_S5CRE, I_S5CIM, I_S5D, I_S5WGLU, I_S5BGLU, I_WROUTER, I_EBIAS, I_WGATE, I_WUP, I_WDOWN,
       I_WSGATE, I_WSUP, I_WSDOWN };

struct Params;
typedef __attribute__((address_space(1))) char g1char;
DEV char* opaque_ptr(char* p) { g1char* g = (g1char*)p; asm volatile("" : "+s"(g)); return (char*)g; }
DEV int opaque_s(int x) { asm volatile("" : "+s"(x)); return x; }
extern __shared__ __attribute__((aligned(16))) char lds_dyn[];
constexpr int LDS_TID_TABLE = 160 * 1024 - 16 - 64;
DEV unsigned hw_wave_slot() { return (unsigned)__builtin_amdgcn_s_getreg((5 << 11) | 4) & 63u; }
DEV int plain_tid() {
    const int wv = __builtin_amdgcn_readfirstlane((int)((volatile LAS unsigned char*)(LAS char*)lds_dyn)[LDS_TID_TABLE + hw_wave_slot()]);
    int lane;
    asm volatile("v_mbcnt_lo_u32_b32 %0, -1, 0\n\tv_mbcnt_hi_u32_b32 %0, -1, %0" : "=v"(lane));
    return (wv << 6) | lane;
}
DEV int opaque_tid() { int t = plain_tid(); asm volatile("" : "+v"(t)); return t; }

DEV float bf2f(u16 b) { return __uint_as_float(((u32)b) << 16); }
DEV u16 f2bf(float f) { u32 u = __float_as_uint(f); u += 0x7FFFu + ((u >> 16) & 1u); return (u16)(u >> 16); }
typedef __bf16 bf16v2_t __attribute__((ext_vector_type(2)));
typedef float f32v2_t __attribute__((ext_vector_type(2)));
DEV u32 cvt_pk_bf16(float lo, float hi) { f32v2_t v = {lo, hi}; bf16v2_t b = __builtin_convertvector(v, bf16v2_t); return __builtin_bit_cast(u32, b); }
DEV u32 pack2(float lo, float hi) { return cvt_pk_bf16(lo, hi); }
template <int CTRL>
DEV float dppf(float v) { return __int_as_float(__builtin_amdgcn_update_dpp(0, __float_as_int(v), CTRL, 0xF, 0xF, true)); }
DEV float lane_bcast(float v, int l) { return __int_as_float(__builtin_amdgcn_readlane(__float_as_int(v), l)); }
DEV float wave_sum(float v) {
    v += dppf<0xB1>(v); v += dppf<0x4E>(v); v += dppf<0x141>(v); v += dppf<0x140>(v);
    return (lane_bcast(v, 0) + lane_bcast(v, 16)) + (lane_bcast(v, 32) + lane_bcast(v, 48));
}
DEV float xor32(float v) {
    const int l = opaque_tid() & 63;
    return __int_as_float(__builtin_amdgcn_ds_bpermute((l ^ 32) << 2, __float_as_int(v)));
}
DEV float max8(float v) {
    v = fmaxf(v, dppf<0xB1>(v)); v = fmaxf(v, dppf<0x4E>(v)); v = fmaxf(v, dppf<0x141>(v));
    return v;
}
DEV float silu_f(float x) { return x / (1.f + __expf(-x)); }
DEV float sigmoid_f(float x) { return 1.f / (1.f + __expf(-x)); }
DEV float gelu_tanh(float x) {
    const float k = 0.7978845608028654f;
    float u = k * (x + 0.044715f * x * x * x);
    float t = 1.f - 2.f / (1.f + __expf(2.f * u));
    return 0.5f * x * (1.f + t);
}
DEV void unpack8(const uint4& q, float* f) {
    f[0] = __uint_as_float(q.x << 16); f[1] = __uint_as_float(q.x & 0xFFFF0000u);
    f[2] = __uint_as_float(q.y << 16); f[3] = __uint_as_float(q.y & 0xFFFF0000u);
    f[4] = __uint_as_float(q.z << 16); f[5] = __uint_as_float(q.z & 0xFFFF0000u);
    f[6] = __uint_as_float(q.w << 16); f[7] = __uint_as_float(q.w & 0xFFFF0000u);
}
DEV uint4 pack8(const float* f) {
    uint4 q; q.x = pack2(f[0], f[1]); q.y = pack2(f[2], f[3]); q.z = pack2(f[4], f[5]); q.w = pack2(f[6], f[7]); return q;
}
DEV bool tok_lat(int t) { return t < TL; }
DEV int tok_b(int t) { return t < TL ? (t >> 12) : ((t - TL) >> 8); }
DEV int tok_mb(int t) { return t < TL ? (t >> 12) : 8; }
DEV float lam_init_of(int l) { return l == 0 ? 0.2f : (0.8f - 0.6f * 0.7408182206817179f); }

DEV const float* xrow_prev(const Params& P, int l, int t) {
    char* const wsb = opaque_ptr(P.ws);
    if (t < TL) return (l == 0 ? P.in[I_X] : P.out) + (size_t)t * D;
    return (l == 0 ? P.in[I_CTX] : (const float*)(wsb + OFF_CTXS)) + (size_t)(t - TL) * D;
}
DEV float* xrow_cur(const Params& P, int t) {
    char* const wsb = opaque_ptr(P.ws);
    if (t < TL) return P.out + (size_t)t * D;
    return (float*)(wsb + OFF_CTXS) + (size_t)(t - TL) * D;
}

#define XB_TMO      128
#define XB_XCNT(j)  (256  + 64 * (j))
#define XB_XSUB(j)  (1280 + 64 * (j))
#define XB_XGEN(j)  (2304 + 64 * (j))
#define XB_TOP      3328
#define XB_TOPGEN   3392
#define XCD_BAR_WORDS 3456
#define XB_SPIN_CAP (1u << 22)
typedef __attribute__((address_space(1))) unsigned gu32;
__device__ __forceinline__ unsigned xb_ld(gu32* p)              { return __hip_atomic_load(p, __ATOMIC_RELAXED, __HIP_MEMORY_SCOPE_AGENT); }
__device__ __forceinline__ unsigned xb_add(gu32* p, unsigned v) { return __hip_atomic_fetch_add(p, v, __ATOMIC_RELAXED, __HIP_MEMORY_SCOPE_AGENT); }
__device__ __forceinline__ unsigned xb_xcc_id() { return (unsigned)__builtin_amdgcn_s_getreg((3 << 11) | 20) & 0xFu; }
#define XB_SPIN(cond, bar) do { unsigned _sp = 0; while (cond) { __builtin_amdgcn_s_sleep(1); \
    if ((++_sp & 255u) == 0u) { if (xb_ld(&(bar)[XB_TMO])) break; if (_sp > XB_SPIN_CAP) { xb_add(&(bar)[XB_TMO], 1u); break; } } } } while (0)
struct XcdBarrier { unsigned* bar; unsigned x; volatile LAS unsigned* st; };
__device__ __forceinline__ XcdBarrier xcd_barrier_post(unsigned* bar, volatile LAS unsigned* st) {
    XcdBarrier b; b.bar = bar; b.x = xb_xcc_id(); b.st = st;
    if (plain_tid() == 0) (void)xb_add(&((gu32*)bar)[XB_XCNT(b.x)], 1u);
    return b;
}
__device__ __forceinline__ void xcd_barrier_complete(gu32* bar, unsigned x, unsigned& nloc, unsigned& nx) {
    const unsigned G = gridDim.x * gridDim.y * gridDim.z;
    unsigned sum, cnt, mine, sp = 0u;
    for (;;) {
        sum = 0u; cnt = 0u; mine = 0u;
#pragma unroll
        for (unsigned j = 0; j < 16; ++j) { const unsigned c = xb_ld(&bar[XB_XCNT(j)]); sum += c; cnt += (c > 0u) ? 1u : 0u; mine = (j == x) ? c : mine; }
        if (sum == G) break;
        __builtin_amdgcn_s_sleep(1);
        if ((++sp & 255u) == 0u) { if (xb_ld(&bar[XB_TMO])) break; if (sp > XB_SPIN_CAP) { xb_add(&bar[XB_TMO], 1u); break; } }
    }
    nloc = mine > 0u ? mine : 1u; nx = cnt > 0u ? cnt : 1u;
}
__device__ __forceinline__ void xcd_barrier(const XcdBarrier& b) {
    asm volatile("s_waitcnt vmcnt(0)" ::: "memory");
    __syncthreads();
    if (plain_tid() == 0) {
        gu32* bar = (gu32*)opaque_ptr((char*)b.bar);
        unsigned bx = b.x; asm volatile("" : "+s"(bx));
        __builtin_amdgcn_s_waitcnt(0);
        unsigned nloc = b.st[0], nx = b.st[1];
        if (nloc == 0u) { xcd_barrier_complete(bar, bx, nloc, nx); b.st[0] = nloc; b.st[1] = nx; }
        const unsigned old = xb_add(&bar[XB_XSUB(bx)], 1u);
        const unsigned gen = old / nloc;
        if (old + 1u == (gen + 1u) * nloc) {
            __builtin_amdgcn_fence(__ATOMIC_RELEASE, "agent");
            asm volatile("s_waitcnt vmcnt(0)" ::: "memory");
            const unsigned og = xb_add(&bar[XB_TOP], 1u);
            const unsigned tg = og / nx;
            if (og + 1u == (tg + 1u) * nx) xb_add(&bar[XB_TOPGEN], 1u);
            else XB_SPIN(xb_ld(&bar[XB_TOPGEN]) == tg, bar);
            __builtin_amdgcn_fence(__ATOMIC_ACQUIRE, "agent");
            xb_add(&bar[XB_XGEN(bx)], 1u);
            asm volatile("s_waitcnt vmcnt(0)" ::: "memory");
        } else {
            XB_SPIN(xb_ld(&bar[XB_XGEN(bx)]) == gen, bar);
            __builtin_amdgcn_fence(__ATOMIC_ACQUIRE, "agent");
            asm volatile("s_waitcnt vmcnt(0)" ::: "memory");
        }
    }
    __syncthreads();
}

constexpr int BK = 64, HALF = 128, HT = HALF * BK;

DEV int lds_byte(int r, int c) {
    int st = (r >> 4) * 2 + (c >> 5), rr = r & 15, cc = c & 31, ob = rr * 64 + cc * 2;
    return st * 1024 + (ob ^ (((ob >> 9) & 1) << 5));
}
DEV void stage_rc(int b, int& R, int& C) {
    int st = b / 1024, sb = b % 1024, swz = sb ^ (((sb >> 9) & 1) << 5);
    R = (st >> 1) * 16 + swz / 64; C = (st & 1) * 32 + (swz % 64) / 2;
}

template <class AOff>
DEV void gemm_tile_core(const u16* __restrict__ Abase, AOff aoffA, const u16* __restrict__ Bt, const int Kin, char* lds) {
    const int tidx = opaque_tid();
    u16* Cs = (u16*)lds;
    int K = Kin; asm volatile("" : "+s"(K));
    u16* shm = (u16*)lds;
#define SA(b, h) (shm + ((b) * 2 + (h)) * HT)
#define SB(b, h) (shm + (4 + (b) * 2 + (h)) * HT)
#define STAGE_A(TZ, P, h, kt) do { \
    for (int _i = 0; _i < 2; ++_i) { const int _b = (TZ) * 16 + _i * 8192; \
      __builtin_amdgcn_global_load_lds((const unsigned*)((const char*)Abase + (size_t)(u32)(voa[h][_i] + (u32)(kt) * (BK * 2))), \
        (LAS unsigned*)((LAS char*)(P) + _b), 16, 0, 0); } } while (0)
#define STAGE_B(TZ, P, h, kt) do { const char* _bb = (const char*)(Bt + (size_t)(h) * HALF * K); \
    for (int _i = 0; _i < 2; ++_i) { const int _b = (TZ) * 16 + _i * 8192; \
      __builtin_amdgcn_global_load_lds((const unsigned*)(_bb + (size_t)(u32)(vob[_i] + (u32)(kt) * (BK * 2))), \
        (LAS unsigned*)((LAS char*)(P) + _b), 16, 0, 0); } } while (0)
#define LDA(dst, b, h) for (int m = 0; m < 4; ++m) for (int k = 0; k < 2; ++k) \
    dst[m][k] = *reinterpret_cast<const bf16x8*>((char*)SA(b, h) + lds_byte(wr * 64 + m * 16 + fr, k * 32 + fq * 8))
#define LDB(dst, b, h) for (int n = 0; n < 2; ++n) for (int k = 0; k < 2; ++k) \
    dst[n][k] = *reinterpret_cast<const bf16x8*>((char*)SB(b, h) + lds_byte(wc * 32 + n * 16 + fr, k * 32 + fq * 8))
#define MMA(ai, bj, At, Bx) do { __builtin_amdgcn_s_setprio(1); \
    for (int m = 0; m < 4; ++m) for (int n = 0; n < 2; ++n) for (int k = 0; k < 2; ++k) \
      acc[ai][bj][m][n] = __builtin_amdgcn_mfma_f32_16x16x32_bf16(Bx[n][k], At[m][k], acc[ai][bj][m][n], 0, 0, 0); \
    __builtin_amdgcn_s_setprio(0); } while (0)
#define WAIT_V(n) asm volatile("s_waitcnt vmcnt(" #n ")" ::: "memory")
#define WAIT_L(n) asm volatile("s_waitcnt lgkmcnt(" #n ")" ::: "memory")
#define BAR __builtin_amdgcn_s_barrier()
#define SCHED __builtin_amdgcn_sched_barrier(0)
    int wid = tidx >> 6, lane = tidx & 63, wr = wid >> 2, wc = wid & 3, fr = lane & 15, fq = lane >> 4;
    u32 voa[2][2], vob[2];
    const int tz0 = opaque_tid();
    {
        for (int i = 0; i < 2; ++i) {
            int _b = tz0 * 16 + i * 8192; int _r, _c; stage_rc(_b, _r, _c);
            vob[i] = (u32)(_r * K + _c) * 2u;
            for (int h = 0; h < 2; ++h) voa[h][i] = (aoffA(h * HALF + _r) + (u32)_c) * 2u;
        }
    }
    f32x4 acc[2][2][4][2] = {};
    bf16x8 At[4][2], B0[2][2], B1[2][2];
    const int nt = K / BK;
    __syncthreads();
    STAGE_B(tidx, SB(0, 0), 0, 0); STAGE_A(tidx, SA(0, 0), 0, 0);
    STAGE_B(tidx, SB(0, 1), 1, 0); STAGE_A(tidx, SA(0, 1), 1, 0);
    if (wr == 1) BAR;
    WAIT_V(4); BAR;
    STAGE_B(tidx, SB(1, 0), 0, 1); STAGE_A(tidx, SA(1, 0), 0, 1); STAGE_B(tidx, SB(1, 1), 1, 1);
    WAIT_V(6); BAR;
    for (int t = 0; t < nt - 2; t += 2) {
        LDB(B0, 0, 0); SCHED; LDA(At, 0, 0); STAGE_A(tidx, SA(1, 1), 1, t + 1);
        WAIT_L(8); BAR; WAIT_L(0); MMA(0, 0, At, B0); BAR; SCHED;
        LDB(B1, 0, 1); STAGE_B(tidx, SB(0, 0), 0, t + 2);
        BAR; WAIT_L(0); MMA(0, 1, At, B1); BAR;
        LDA(At, 0, 1); STAGE_A(tidx, SA(0, 0), 0, t + 2);
        BAR; WAIT_L(0); MMA(1, 0, At, B0); BAR; SCHED;
        STAGE_B(tidx, SB(0, 1), 1, t + 2);
        WAIT_V(6); BAR; MMA(1, 1, At, B1); BAR;
        LDB(B0, 1, 0); SCHED; LDA(At, 1, 0); STAGE_A(tidx, SA(0, 1), 1, t + 2);
        WAIT_L(8); BAR; WAIT_L(0); MMA(0, 0, At, B0); BAR; SCHED;
        LDB(B1, 1, 1); STAGE_B(tidx, SB(1, 0), 0, t + 3);
        BAR; WAIT_L(0); MMA(0, 1, At, B1); BAR;
        LDA(At, 1, 1); STAGE_A(tidx, SA(1, 0), 0, t + 3);
        BAR; WAIT_L(0); MMA(1, 0, At, B0); BAR; SCHED;
        STAGE_B(tidx, SB(1, 1), 1, t + 3);
        WAIT_V(6); BAR; MMA(1, 1, At, B1); BAR;
    }
    int tz = tidx; asm volatile("" : "+v"(tz)); wid = tz >> 6; lane = tz & 63; wr = wid >> 2; wc = wid & 3; fr = lane & 15; fq = lane >> 4;
    { LDB(B0, 0, 0); WAIT_V(0); LDA(At, 0, 0); STAGE_A(tz, SA(1, 1), 1, nt - 1);
      BAR; WAIT_L(0); MMA(0, 0, At, B0); BAR;
      LDB(B1, 0, 1); BAR; WAIT_L(0); MMA(0, 1, At, B1); BAR;
      LDA(At, 0, 1); WAIT_V(4); BAR; WAIT_L(0); MMA(1, 0, At, B0); MMA(1, 1, At, B1); BAR; }
    { LDB(B0, 1, 0); LDA(At, 1, 0); WAIT_V(2); BAR; WAIT_L(0); MMA(0, 0, At, B0); BAR;
      LDB(B1, 1, 1); WAIT_V(0); BAR; WAIT_L(0); MMA(0, 1, At, B1); BAR;
      LDA(At, 1, 1); BAR; WAIT_L(0); MMA(1, 0, At, B0); MMA(1, 1, At, B1); BAR; }
    if (wr == 0) BAR;
    __syncthreads();
    for (int ai = 0; ai < 2; ++ai) for (int bj = 0; bj < 2; ++bj) for (int m = 0; m < 4; ++m) for (int n = 0; n < 2; ++n) {
        uint2 pk; pk.x = cvt_pk_bf16(acc[ai][bj][m][n][0], acc[ai][bj][m][n][1]); pk.y = cvt_pk_bf16(acc[ai][bj][m][n][2], acc[ai][bj][m][n][3]);
        *(uint2*)(Cs + (ai * HALF + wr * 64 + m * 16 + fr) * CS_STRIDE + (bj * HALF + wc * 32 + n * 16 + fq * 4)) = pk;
    }
    __syncthreads();
#undef SA
#undef SB
#undef STAGE_A
#undef STAGE_B
#undef LDA
#undef LDB
#undef MMA
}

struct GemmPre { const u16* Abase; const u16* Bt; u32 voa[2][2]; u32 vob[2]; int K; };
template <class AOff>
DEV void gemm_pre_make(GemmPre& g, const u16* Abase, AOff aoffA, const u16* Bt, int K) {
    const int tz0 = opaque_tid();
    g.Abase = Abase; g.Bt = Bt; g.K = K;
#pragma unroll
    for (int i = 0; i < 2; ++i) {
        int _b = tz0 * 16 + i * 8192; int _r, _c; stage_rc(_b, _r, _c);
        g.vob[i] = (u32)(_r * K + _c) * 2u;
#pragma unroll
        for (int h = 0; h < 2; ++h) g.voa[h][i] = (aoffA(h * HALF + _r) + (u32)_c) * 2u;
    }
}
#define GP_STAGE_A(G, P, h, kt) do { \
    for (int _i = 0; _i < 2; ++_i) { const int _b = tidx * 16 + _i * 8192; \
      __builtin_amdgcn_global_load_lds((const unsigned*)((const char*)(G).Abase + (size_t)(u32)((G).voa[h][_i] + (u32)(kt) * (BK * 2))), \
        (LAS unsigned*)((LAS char*)(P) + _b), 16, 0, 0); } } while (0)
#define GP_STAGE_B(G, P, h, kt) do { const char* _bb = (const char*)((G).Bt + (size_t)(h) * HALF * (G).K); \
    for (int _i = 0; _i < 2; ++_i) { const int _b = tidx * 16 + _i * 8192; \
      __builtin_amdgcn_global_load_lds((const unsigned*)(_bb + (size_t)(u32)((G).vob[_i] + (u32)(kt) * (BK * 2))), \
        (LAS unsigned*)((LAS char*)(P) + _b), 16, 0, 0); } } while (0)
DEV void gemm_pre_issue(const GemmPre& g, char* lds) {
    const int tidx = opaque_tid();
    u16* shm = (u16*)lds;
    GP_STAGE_B(g, (shm + (4 + 0) * HT), 0, 0); GP_STAGE_A(g, (shm + 0 * HT), 0, 0);
    GP_STAGE_B(g, (shm + (4 + 1) * HT), 1, 0); GP_STAGE_A(g, (shm + 1 * HT), 1, 0);
}
template <class AfterLoop, class Epi>
DEV void gemm_tile_pipe(const GemmPre& g, char* lds, AfterLoop after_loop, Epi epi) {
    const int tidx = opaque_tid();
    const u16* __restrict__ Abase = g.Abase; const u16* __restrict__ Bt = g.Bt;
    int K = g.K; asm volatile("" : "+s"(K));
    u16* shm = (u16*)lds;
#define SA(b, h) (shm + ((b) * 2 + (h)) * HT)
#define SB(b, h) (shm + (4 + (b) * 2 + (h)) * HT)
#define STAGE_A(TZ, P, h, kt) do { \
    for (int _i = 0; _i < 2; ++_i) { const int _b = (TZ) * 16 + _i * 8192; \
      __builtin_amdgcn_global_load_lds((const unsigned*)((const char*)Abase + (size_t)(u32)(voa[h][_i] + (u32)(kt) * (BK * 2))), \
        (LAS unsigned*)((LAS char*)(P) + _b), 16, 0, 0); } } while (0)
#define STAGE_B(TZ, P, h, kt) do { const char* _bb = (const char*)(Bt + (size_t)(h) * HALF * K); \
    for (int _i = 0; _i < 2; ++_i) { const int _b = (TZ) * 16 + _i * 8192; \
      __builtin_amdgcn_global_load_lds((const unsigned*)(_bb + (size_t)(u32)(vob[_i] + (u32)(kt) * (BK * 2))), \
        (LAS unsigned*)((LAS char*)(P) + _b), 16, 0, 0); } } while (0)
#define LDA(dst, b, h) for (int m = 0; m < 4; ++m) for (int k = 0; k < 2; ++k) \
    dst[m][k] = *reinterpret_cast<const bf16x8*>((char*)SA(b, h) + lds_byte(wr * 64 + m * 16 + fr, k * 32 + fq * 8))
#define LDB(dst, b, h) for (int n = 0; n < 2; ++n) for (int k = 0; k < 2; ++k) \
    dst[n][k] = *reinterpret_cast<const bf16x8*>((char*)SB(b, h) + lds_byte(wc * 32 + n * 16 + fr, k * 32 + fq * 8))
#define MMA(ai, bj, At, Bx) do { __builtin_amdgcn_s_setprio(1); \
    for (int m = 0; m < 4; ++m) for (int n = 0; n < 2; ++n) for (int k = 0; k < 2; ++k) \
      acc[ai][bj][m][n] = __builtin_amdgcn_mfma_f32_16x16x32_bf16(Bx[n][k], At[m][k], acc[ai][bj][m][n], 0, 0, 0); \
    __builtin_amdgcn_s_setprio(0); } while (0)
#define WAIT_V(n) asm volatile("s_waitcnt vmcnt(" #n ")" ::: "memory")
#define WAIT_L(n) asm volatile("s_waitcnt lgkmcnt(" #n ")" ::: "memory")
#define BAR __builtin_amdgcn_s_barrier()
#define SCHED __builtin_amdgcn_sched_barrier(0)
    int wid = tidx >> 6, lane = tidx & 63, wr = wid >> 2, wc = wid & 3, fr = lane & 15, fq = lane >> 4;
    u32 voa[2][2], vob[2];
    voa[0][0] = g.voa[0][0]; voa[0][1] = g.voa[0][1]; voa[1][0] = g.voa[1][0]; voa[1][1] = g.voa[1][1]; vob[0] = g.vob[0]; vob[1] = g.vob[1];
    f32x4 acc[2][2][4][2] = {};
    bf16x8 At[4][2], B0[2][2], B1[2][2];
    const int nt = K / BK;
    if (wr == 1) BAR;
    WAIT_V(4); BAR;
    STAGE_B(tidx, SB(1, 0), 0, 1); STAGE_A(tidx, SA(1, 0), 0, 1); STAGE_B(tidx, SB(1, 1), 1, 1);
    WAIT_V(6); BAR;
    for (int t = 0; t < nt - 2; t += 2) {
        LDB(B0, 0, 0); SCHED; LDA(At, 0, 0); STAGE_A(tidx, SA(1, 1), 1, t + 1);
        WAIT_L(8); BAR; WAIT_L(0); MMA(0, 0, At, B0); BAR; SCHED;
        LDB(B1, 0, 1); STAGE_B(tidx, SB(0, 0), 0, t + 2);
        BAR; WAIT_L(0); MMA(0, 1, At, B1); BAR;
        LDA(At, 0, 1); STAGE_A(tidx, SA(0, 0), 0, t + 2);
        BAR; WAIT_L(0); MMA(1, 0, At, B0); BAR; SCHED;
        STAGE_B(tidx, SB(0, 1), 1, t + 2);
        WAIT_V(6); BAR; MMA(1, 1, At, B1); BAR;
        LDB(B0, 1, 0); SCHED; LDA(At, 1, 0); STAGE_A(tidx, SA(0, 1), 1, t + 2);
        WAIT_L(8); BAR; WAIT_L(0); MMA(0, 0, At, B0); BAR; SCHED;
        LDB(B1, 1, 1); STAGE_B(tidx, SB(1, 0), 0, t + 3);
        BAR; WAIT_L(0); MMA(0, 1, At, B1); BAR;
        LDA(At, 1, 1); STAGE_A(tidx, SA(1, 0), 0, t + 3);
        BAR; WAIT_L(0); MMA(1, 0, At, B0); BAR; SCHED;
        STAGE_B(tidx, SB(1, 1), 1, t + 3);
        WAIT_V(6); BAR; MMA(1, 1, At, B1); BAR;
    }
    int tz = tidx; asm volatile("" : "+v"(tz)); wid = tz >> 6; lane = tz & 63; wr = wid >> 2; wc = wid & 3; fr = lane & 15; fq = lane >> 4;
    { LDB(B0, 0, 0); WAIT_V(0); LDA(At, 0, 0); STAGE_A(tz, SA(1, 1), 1, nt - 1);
      BAR; WAIT_L(0); MMA(0, 0, At, B0); BAR;
      LDB(B1, 0, 1); BAR; WAIT_L(0); MMA(0, 1, At, B1); BAR;
      LDA(At, 0, 1); WAIT_V(4); BAR; WAIT_L(0); MMA(1, 0, At, B0); MMA(1, 1, At, B1); BAR; }
    { LDB(B0, 1, 0); LDA(At, 1, 0); WAIT_V(2); BAR; WAIT_L(0); MMA(0, 0, At, B0); BAR;
      LDB(B1, 1, 1); WAIT_V(0); BAR; WAIT_L(0); MMA(0, 1, At, B1); BAR;
      LDA(At, 1, 1); BAR; WAIT_L(0); MMA(1, 0, At, B0); MMA(1, 1, At, B1); BAR; }
    if (wr == 0) BAR;
    __syncthreads();
    after_loop();
    epi(acc, wr, wc, fr, fq);
#undef SA
#undef SB
#undef STAGE_A
#undef STAGE_B
#undef LDA
#undef LDB
#undef MMA
}


DEV void convert_tile(const float* __restrict__ src, u16* __restrict__ dst, int K, int N, int mode, int tile, char* lds) {
    const int tidx = opaque_tid();
    float* tl = (float*)lds;
    const int ntn = N / 64;
    const int tk = tile / ntn, tn = tile % ntn;
    const int t = tidx;
    __syncthreads();
    {
        const int kk = t >> 4, n4 = (t & 15) * 4;
#pragma unroll
        for (int i = 0; i < 2; ++i) {
            const int k = kk + i * 32;
            const float4 v = *(const float4*)(src + (size_t)(tk * 64 + k) * N + tn * 64 + n4);
            tl[k * 65 + n4 + 0] = v.x; tl[k * 65 + n4 + 1] = v.y; tl[k * 65 + n4 + 2] = v.z; tl[k * 65 + n4 + 3] = v.w;
        }
    }
    __syncthreads();
    {
        const int n = t >> 3, k8 = (t & 7) * 8;
        float f[8];
#pragma unroll
        for (int i = 0; i < 8; ++i) f[i] = tl[(k8 + i) * 65 + n];
        const int c = tn * 64 + n;
        int row = c;
        if (mode == 1) row = (c >> 7) * 256 + (c & 127);
        else if (mode == 2) row = (c >> 7) * 256 + 128 + (c & 127);
        *(uint4*)(dst + (size_t)row * K + tk * 64 + k8) = pack8(f);
    }
}
DEV void convert_set(const float* src, size_t src_mat_stride, u16* dst, size_t dst_mat_stride, int nmat, int K, int N, int mode, int bid, int nb, char* lds) {
    const int tpm = (K / 64) * (N / 64);
    for (int i = bid; i < nmat * tpm; i += nb) {
        const int m = i / tpm, tile = i % tpm;
        convert_tile(src + (size_t)m * src_mat_stride, dst + (size_t)m * dst_mat_stride, K, N, mode, tile, lds);
    }
}

DEV void phase_init(const Params& P, int bid, int nb, char* lds) {
    char* const wsb = opaque_ptr(P.ws);
    const int tidx = opaque_tid();
    const int t = tidx;
    convert_set(P.in[I_WIN], (size_t)D * INC, (u16*)(wsb + OFF_WIN), (size_t)INC * D, 2, D, INC, 0, bid, nb, lds);
    convert_set(P.in[I_WOUT], (size_t)D * D, (u16*)(wsb + OFF_WOUT), (size_t)D * D, 2, D, D, 0, bid, nb, lds);
    convert_set(P.in[I_S5WGLU], (size_t)256 * 256, (u16*)(wsb + OFF_WGLU), (size_t)256 * 256, 2, 256, 256, 0, bid, nb, lds);
    convert_set(P.in[I_WSGATE], (size_t)D * 256, (u16*)(wsb + OFF_WSH1), (size_t)512 * D, 2, D, 256, 1, bid, nb, lds);
    convert_set(P.in[I_WSUP], (size_t)D * 256, (u16*)(wsb + OFF_WSH1), (size_t)512 * D, 2, D, 256, 2, bid, nb, lds);
    convert_set(P.in[I_WSDOWN], (size_t)256 * D, (u16*)(wsb + OFF_WSH2), (size_t)D * 256, 2, 256, D, 0, bid, nb, lds);
    __syncthreads();
    float* cond = (float*)lds;
    float* red = (float*)(lds + 9 * 1024 * 4);
    for (int i = t; i < 9 * 1024; i += NTHREADS) {
        const int r = i >> 10, k = i & 1023;
        const float v = (r < 8) ? P.in[I_C][r * 1024 + k] : P.in[I_CCTX][k];
        cond[i] = silu_f(v);
    }
    __syncthreads();
    float* mod = (float*)(wsb + OFF_MOD);
    for (int job = bid; job < 192; job += nb) {
        const int l = job / 96, n0 = (job % 96) * 64;
        const int w = t >> 6, lane = t & 63;
        float acc[9];
#pragma unroll
        for (int r = 0; r < 9; ++r) acc[r] = 0.f;
        const float* wm = P.in[I_WMOD] + (size_t)l * D * 6144 + n0 + lane;
#pragma unroll 1
        for (int k0 = w * 128; k0 < (w + 1) * 128; k0 += 16) {
            float wv[16];
#pragma unroll
            for (int kk = 0; kk < 16; ++kk) wv[kk] = wm[(size_t)(k0 + kk) * 6144];
#pragma unroll
            for (int kk = 0; kk < 16; ++kk)
#pragma unroll
                for (int r = 0; r < 9; ++r) acc[r] += cond[r * 1024 + k0 + kk] * wv[kk];
        }
#pragma unroll
        for (int r = 0; r < 9; ++r) red[(w * 9 + r) * 64 + lane] = acc[r];
        __syncthreads();
        for (int i = t; i < 9 * 64; i += NTHREADS) {
            const int r = i >> 6, ln = i & 63;
            float s = 0.f;
#pragma unroll
            for (int ww = 0; ww < 8; ++ww) s += red[(ww * 9 + r) * 64 + ln];
            mod[((size_t)l * 9 + r) * 6144 + n0 + ln] = s + P.in[I_BMOD][l * 6144 + n0 + ln];
        }
        __syncthreads();
    }
    if (bid == 0) {
        float* rope = (float*)(wsb + OFF_ROPE);
        if (t < 512) {
            const int v = t >> 3, i = t & 7;
            const float inv = powf(10000.f, -(float)i / 8.f);
            const float ang = (float)v * inv;
            rope[t] = cosf(ang);
            rope[512 + t] = sinf(ang);
        }
        if (t < 2) {
            const float* lv = P.in[I_ALAM] + t * 4 * 32;
            float s01 = 0.f, s23 = 0.f;
            for (int i = 0; i < 32; ++i) { s01 += lv[i] * lv[32 + i]; s23 += lv[64 + i] * lv[96 + i]; }
            ((float*)(wsb + OFF_MISC))[t] = expf(s01) - expf(s23) + lam_init_of(t);
        }
    }
}

DEV void conv_load(const float* __restrict__ src, int N, int k0, int n0, int tidx, float4 (&v)[8]) {
    const int kk = tidx >> 6, n4 = (tidx & 63) * 4;
#pragma unroll
    for (int i = 0; i < 8; ++i) v[i] = *(const float4*)(src + (size_t)(k0 + kk + i * 8) * N + n0 + n4);
}
DEV void conv_jobs(const Params& P, int l, int i0, int iend, int step, char* lds) {
    char* const wsb = opaque_ptr(P.ws);
    const int tidx = opaque_tid();
    float* tl = (float*)lds;
    f32x4 v[8];
    int i = i0;
    if (i >= iend) return;
    const float* src = nullptr; u16* dst = nullptr; int K = 0, N = 0, mode = 0, k0 = 0, n0 = 0;
#define CONV_LOAD() do { const int _kk = tidx >> 6, _n4 = (tidx & 63) * 4; _Pragma("unroll") for (int _i = 0; _i < 8; ++_i) v[_i] = *(const f32x4*)(src + (size_t)(k0 + _kk + _i * 8) * N + n0 + _n4); } while (0)
#define CONV_JOB(ji) do { const int _mat = (ji) >> 4, _t = (ji) & 15; const int _kind = _mat >> 6, _e = _mat & 63; \
        if (_kind < 2) { src = P.in[_kind == 0 ? I_WGATE : I_WUP] + ((size_t)l * NEXP + _e) * D * 256; dst = (u16*)(wsb + OFF_W1) + (size_t)_e * 512 * D; \
            K = D; N = 256; mode = _kind + 1; k0 = _t * 64; n0 = 0; } \
        else { src = P.in[I_WDOWN] + ((size_t)l * NEXP + _e) * 256 * D; dst = (u16*)(wsb + OFF_W2) + (size_t)_e * D * 256; \
            K = 256; N = D; mode = 0; k0 = (_t >> 2) * 64; n0 = (_t & 3) * 256; } } while (0)
    { CONV_JOB(i); CONV_LOAD(); }
    for (; i < iend; i += step) {
        __syncthreads();
        {
            const int kk = tidx >> 6, n4 = (tidx & 63) * 4;
#pragma unroll
            for (int j = 0; j < 8; ++j) *(f32x4*)(tl + (kk + j * 8) * 260 + n4) = v[j];
        }
        __syncthreads();
        u16* cdst = dst; const int cK = K, cmode = mode, ck0 = k0, cn0 = n0;
        { const int jn = (i + step < iend) ? i + step : i; CONV_JOB(jn); CONV_LOAD(); }
        {
            const int n = tidx & 255, kh = tidx >> 8;
            float f[32];
#pragma unroll
            for (int kk = 0; kk < 32; ++kk) f[kk] = tl[(kh * 32 + kk) * 260 + n];
            const int c = cn0 + n;
            int row = c;
            if (cmode == 1) row = (c >> 7) * 256 + (c & 127);
            else if (cmode == 2) row = (c >> 7) * 256 + 128 + (c & 127);
            u16* o = cdst + (size_t)row * cK + ck0 + kh * 32;
#pragma unroll
            for (int j = 0; j < 4; ++j) *(uint4*)(o + j * 8) = pack8(f + j * 8);
        }
    }
    __syncthreads();
#undef CONV_LOAD
#undef CONV_JOB
}
constexpr int CONV_NJOB = 192 * 16;
constexpr int CONV_Q = 8;
constexpr int cmin(int a, int b) { return a < b ? a : b; }
constexpr int INPROJ_TILES0 = 128 * 10 + 8 * 10, INPROJ_TILES1 = 128 * 10 + 8 * 7, OUTPROJ_TILES0 = 136 * 4;
constexpr int INPROJ_BUSY0 = INPROJ_TILES0 % NBLK, INPROJ_BUSY1 = INPROJ_TILES1 % NBLK, OUTPROJ_BUSY0 = OUTPROJ_TILES0 % NBLK;
constexpr int CONV_J1_0 = cmin((NBLK - INPROJ_BUSY0) * CONV_Q, CONV_NJOB), CONV_J1_1 = cmin((NBLK - INPROJ_BUSY1) * CONV_Q, CONV_NJOB);
constexpr int CONV_J2_0 = cmin(CONV_J1_0 + (NBLK - OUTPROJ_BUSY0) * CONV_Q, CONV_NJOB);
static_assert(INPROJ_BUSY0 > 0 && INPROJ_BUSY1 > 0 && OUTPROJ_BUSY0 > 0 && CONV_J2_0 <= CONV_NJOB && CONV_J1_1 <= CONV_NJOB, "conversion job split");
DEV void phase_prep(const Params& P, int l, int bid, int nb, char* lds) {
    char* const wsb = opaque_ptr(P.ws);
    const int tidx = opaque_tid();
    conv_jobs(P, l, (l == 0 ? CONV_J2_0 : CONV_J1_1) + bid, CONV_NJOB, nb, lds);
    const int w = tidx >> 6, lane = tidx & 63;
    const float* mod = (const float*)(wsb + OFF_MOD) + (size_t)l * 9 * 6144;
    const float* g = P.in[I_GMIX] + l * D;
    u16* hb = (u16*)(wsb + OFF_HBUF);
    int tk = bid * 8 + w;
    float4 v[4];
    {
        const float* xr = xrow_prev(P, l, tk < TT ? tk : 0);
#pragma unroll
        for (int i = 0; i < 4; ++i) v[i] = *(const float4*)(xr + lane * 4 + i * 256);
    }
    for (; tk < TT; tk += nb * 8) {
        float4 c4[4];
#pragma unroll
        for (int i = 0; i < 4; ++i) c4[i] = v[i];
        {
            const int tn = tk + nb * 8;
            const float* xr = xrow_prev(P, l, tn < TT ? tn : tk);
#pragma unroll
            for (int i = 0; i < 4; ++i) v[i] = *(const float4*)(xr + lane * 4 + i * 256);
        }
        const float* mrow = mod + (size_t)tok_mb(tk) * 6144;
        float ss = 0.f;
#pragma unroll
        for (int i = 0; i < 4; ++i) ss += c4[i].x * c4[i].x + c4[i].y * c4[i].y + c4[i].z * c4[i].z + c4[i].w * c4[i].w;
        ss = wave_sum(ss);
        const float rinv = rsqrtf(ss * (1.f / 1024.f) + EPS);
#pragma unroll
        for (int i = 0; i < 4; ++i) {
            const int c = lane * 4 + i * 256;
            const float4 gg = *(const float4*)(g + c);
            const float4 sh = *(const float4*)(mrow + c);
            const float4 sc = *(const float4*)(mrow + 1024 + c);
            uint2 o;
            o.x = pack2(c4[i].x * rinv * gg.x * (1.f + sc.x) + sh.x, c4[i].y * rinv * gg.y * (1.f + sc.y) + sh.y);
            o.y = pack2(c4[i].z * rinv * gg.z * (1.f + sc.z) + sh.z, c4[i].w * rinv * gg.w * (1.f + sc.w) + sh.w);
            *(uint2*)(hb + (size_t)tk * D + c) = o;
        }
    }
}

DEV void rope32(float* y, const float* rope, int row, int col) {
#pragma unroll
    for (int hf = 0; hf < 2; ++hf) {
        const int pv = hf == 0 ? row : col;
        const float* cs = rope + pv * 8;
        const float* sn = rope + 512 + pv * 8;
#pragma unroll
        for (int i = 0; i < 8; ++i) {
            const float x1 = y[hf * 16 + i], x2 = y[hf * 16 + 8 + i];
            const float c = cs[i], s = sn[i];
            y[hf * 16 + i] = x1 * c - x2 * s;
            y[hf * 16 + 8 + i] = x1 * s + x2 * c;
        }
    }
}

DEV void inproj_epilogue(const Params& P, int l, int mt, int nt_, char* lds) {
    char* const wsb = opaque_ptr(P.ws);
    const u16* Cs = (const u16*)lds;
    const int t = opaque_tid();
    const bool lat = mt < 128;
    const int b = lat ? (mt >> 4) : (mt - 128);
    const int pos0 = lat ? (mt & 15) * 256 : 0;
    const float* rope = (const float*)(wsb + OFF_ROPE);
    for (int hs = 0; hs < 2; ++hs) {
        const int c0 = nt_ * 256 + hs * 128;
        int seg, segstart;
        if (c0 < 384) { seg = 0; segstart = 0; } else if (c0 < 768) { seg = 1; segstart = 384; } else if (c0 < 1152) { seg = 2; segstart = 768; }
        else if (c0 < 1536) { seg = 3; segstart = 1152; } else if (c0 < 1920) { seg = 4; segstart = 1536; } else if (c0 < 2304) { seg = 5; segstart = 1920; }
        else { seg = 6; segstart = 2304; }
        if (seg == 3 || seg == 5) {
            const int col = t & 127, tq = t >> 7;
            const int hh = (c0 - segstart) / 64 + (col >> 6), dv = col & 63;
            u16* vt = (u16*)(wsb + (seg == 3 ? OFF_VAT : OFF_VNT)) + ((size_t)(b * 6 + hh) * 64 + dv) * NKEY + (lat ? pos0 : SEQ);
#pragma unroll
            for (int g16 = 0; g16 < 4; ++g16) {
                const int r0 = tq * 64 + g16 * 16;
                u16 v[16];
#pragma unroll
                for (int i = 0; i < 16; ++i) v[i] = Cs[(r0 + i) * CS_STRIDE + hs * 128 + col];
                uint4 q0, q1;
                q0.x = (u32)v[0] | ((u32)v[1] << 16);   q0.y = (u32)v[2] | ((u32)v[3] << 16);
                q0.z = (u32)v[8] | ((u32)v[9] << 16);   q0.w = (u32)v[10] | ((u32)v[11] << 16);
                q1.x = (u32)v[4] | ((u32)v[5] << 16);   q1.y = (u32)v[6] | ((u32)v[7] << 16);
                q1.z = (u32)v[12] | ((u32)v[13] << 16); q1.w = (u32)v[14] | ((u32)v[15] << 16);
                *(uint4*)(vt + r0) = q0;
                *(uint4*)(vt + r0 + 8) = q1;
            }
        } else {
            const int r = t >> 1, sub = t & 1;
            const int pos = pos0 + r;
            float v[64];
#pragma unroll
            for (int i = 0; i < 8; ++i) unpack8(*(const uint4*)(Cs + r * CS_STRIDE + hs * 128 + sub * 64 + i * 8), v + i * 8);
            const int hh = (c0 - segstart) / 64 + sub;
            if (seg == 0 || seg == 2) {
                const float* g = P.in[seg == 0 ? I_AGQ : I_AGK] + l * 32;
                const float qs = seg == 0 ? 0.17677669529663687f * LOG2E : 1.f;
#pragma unroll
                for (int s = 0; s < 2; ++s) {
                    float ss = 0.f;
#pragma unroll
                    for (int i = 0; i < 32; ++i) ss += v[s * 32 + i] * v[s * 32 + i];
                    const float rinv = rsqrtf(ss * (1.f / 32.f) + EPS);
#pragma unroll
                    for (int i = 0; i < 32; ++i) v[s * 32 + i] = v[s * 32 + i] * rinv * g[i];
                    if (lat) rope32(v + s * 32, rope, pos >> 6, pos & 63);
#pragma unroll
                    for (int i = 0; i < 32; ++i) v[s * 32 + i] *= qs;
                }
                if (seg == 0) {
#pragma unroll
                    for (int s = 0; s < 2; ++s) {
                        u16* dst = lat ? (u16*)(wsb + OFF_QA) + ((size_t)((b * 6 + hh) * 2 + s) * SEQ + pos) * 32
                                       : (u16*)(wsb + OFF_QAC) + ((size_t)((b * 6 + hh) * 2 + s) * LCTX + pos) * 32;
#pragma unroll
                        for (int i = 0; i < 4; ++i) *(uint4*)(dst + i * 8) = pack8(v + s * 32 + i * 8);
                    }
                } else {
                    const int key = lat ? pos : SEQ + pos;
                    u16* dst = (u16*)(wsb + OFF_KA) + ((size_t)(b * 6 + hh) * NKEY + key) * 64;
#pragma unroll
                    for (int i = 0; i < 8; ++i) *(uint4*)(dst + i * 8) = pack8(v + i * 8);
                }
            } else if (seg == 1 || seg == 4) {
                const float* g = P.in[seg == 1 ? I_NGQ : I_NGK] + l * 64;
                const float qs = seg == 1 ? 0.125f * LOG2E : 1.f;
                float ss = 0.f;
#pragma unroll
                for (int i = 0; i < 64; ++i) ss += v[i] * v[i];
                const float rinv = rsqrtf(ss * (1.f / 64.f) + EPS) * qs;
#pragma unroll
                for (int i = 0; i < 64; ++i) v[i] = v[i] * rinv * g[i];
                u16* dst;
                if (seg == 1) dst = lat ? (u16*)(wsb + OFF_QN) + ((size_t)(b * 6 + hh) * SEQ + pos) * 64 : (u16*)(wsb + OFF_QNC) + ((size_t)(b * 6 + hh) * LCTX + pos) * 64;
                else dst = (u16*)(wsb + OFF_KN) + ((size_t)(b * 6 + hh) * NKEY + (lat ? pos : SEQ + pos)) * 64;
#pragma unroll
                for (int i = 0; i < 8; ++i) *(uint4*)(dst + i * 8) = pack8(v + i * 8);
            } else {
                const int tok = mt * 256 + r;
                u16* dst = (u16*)(wsb + OFF_U) + (size_t)tok * 256 + (c0 - segstart) + sub * 64;
#pragma unroll
                for (int i = 0; i < 8; ++i) *(uint4*)(dst + i * 8) = pack8(v + i * 8);
                {
                    const int fch = lat ? 8 + (pos >> 5) : (pos >> 5), tau = pos & 31;
                    const int g0 = ((c0 - segstart) + sub * 64) >> 4;
#pragma unroll
                    for (int gi = 0; gi < 4; ++gi) {
                        u16* xd = (u16*)(wsb + OFF_XS5) + ((size_t)(g0 + gi) * 1088 + b * 136 + fch) * 768 + 256 + tau * 16;
                        *(uint4*)(xd) = pack8(v + gi * 16);
                        *(uint4*)(xd + 8) = pack8(v + gi * 16 + 8);
                    }
                }
            }
        }
    }
}

DEV void phase_inproj(const Params& P, int l, int bid, int nb, char* lds) {
    char* const wsb = opaque_ptr(P.ws);
    const bool last = (l == 1);
    const u16* A = (const u16*)(wsb + OFF_HBUF);
    const u16* W = (const u16*)(wsb + OFF_WIN) + (size_t)l * INC * D;
    const int nlat = 128 * 10;
    const int nctx = 8 * (last ? 7 : 10);
    for (int i = bid; i < nlat + nctx; i += nb) {
        int mt, nt_;
        if (i < nlat) { mt = i / 10; nt_ = i % 10; }
        else { const int j = i - nlat; if (last) { mt = 128 + j / 7; nt_ = 3 + j % 7; } else { mt = 128 + j / 10; nt_ = j % 10; } }
        const int row0 = mt * 256;
        gemm_tile_core(A, [=](int r) -> u32 { return (u32)(row0 + r) * D; }, W + (size_t)nt_ * 256 * D, D, lds);
        inproj_epilogue(P, l, mt, nt_, lds);
    }
    const int busy = last ? INPROJ_BUSY1 : INPROJ_BUSY0;
    if (nb == NBLK && bid >= busy) conv_jobs(P, l, bid - busy, last ? CONV_J1_1 : CONV_J1_0, NBLK - busy, lds);
    else if (nb != NBLK) conv_jobs(P, l, bid, last ? CONV_J1_1 : CONV_J1_0, nb, lds);
}


DEV f32x16 mfma32(bf16x8 a, bf16x8 b, f32x16 c) { return __builtin_amdgcn_mfma_f32_32x32x16_bf16(a, b, c, 0, 0, 0); }
union FragU { bf16x8 v; u32 u[4]; uint4 q; };
constexpr int KV_ROW = 144;
constexpr int KV_TILE = 64 * KV_ROW;
DEV void attnA_unit(const u16* __restrict__ q0p, const u16* __restrict__ q1p, const u16* __restrict__ kbase, const u16* __restrict__ vbase,
                    int kt0, int kt1, u16* __restrict__ outp, float lam, float li, const float* __restrict__ gsub, char* lds, int tidx_unused) {
    const int tidx = opaque_tid();
    const int w = tidx >> 6, lane = tidx & 63, r = lane & 31, hq = lane >> 5;
    FragU qf[2][2];
#pragma unroll
    for (int ks = 0; ks < 2; ++ks) {
        qf[0][ks].q = *(const uint4*)(q0p + (size_t)(w * 32 + r) * 32 + ks * 16 + hq * 8);
        qf[1][ks].q = *(const uint4*)(q1p + (size_t)(w * 32 + r) * 32 + ks * 16 + hq * 8);
    }
    f32x16 O[2][2];
#pragma unroll
    for (int s = 0; s < 2; ++s)
#pragma unroll
        for (int d = 0; d < 2; ++d)
#pragma unroll
            for (int i = 0; i < 16; ++i) O[s][d][i] = 0.f;
    float rs[2] = {0.f, 0.f};
    const int srow = tidx >> 3, schunk = tidx & 7;
    const u16* kg = kbase + (size_t)srow * 64 + schunk * 8;
    const u16* vg = vbase + (size_t)srow * NKEY + schunk * 8;
    const int soff = srow * KV_ROW + schunk * 16;
    uint4 kreg = *(const uint4*)(kg + (size_t)kt0 * 64 * 64);
    uint4 vreg = *(const uint4*)(vg + (size_t)kt0 * 64);
    __syncthreads();
    for (int t = kt0; t < kt1; ++t) {
        char* Ks = lds + ((t - kt0) & 1) * (2 * KV_TILE);
        char* Vs = Ks + KV_TILE;
        *(uint4*)(Ks + soff) = kreg;
        *(uint4*)(Vs + soff) = vreg;
        __syncthreads();
        if (t + 1 < kt1) {
            kreg = *(const uint4*)(kg + (size_t)(t + 1) * 64 * 64);
            vreg = *(const uint4*)(vg + (size_t)(t + 1) * 64);
        }
        bf16x8 vf[2][4];
#pragma unroll
        for (int d = 0; d < 2; ++d)
#pragma unroll
            for (int g = 0; g < 4; ++g) vf[d][g] = *(const bf16x8*)(Vs + (d * 32 + r) * KV_ROW + (g * 16 + hq * 8) * 2);
#pragma unroll
        for (int s = 0; s < 2; ++s) {
            FragU pf[2][2];
#pragma unroll
            for (int kt = 0; kt < 2; ++kt) {
                f32x16 acc;
#pragma unroll
                for (int i = 0; i < 16; ++i) acc[i] = 0.f;
#pragma unroll
                for (int ks = 0; ks < 2; ++ks) {
                    FragU kf; kf.q = *(const uint4*)(Ks + (kt * 32 + r) * KV_ROW + s * 64 + ks * 32 + hq * 16);
                    acc = mfma32(kf.v, qf[s][ks].v, acc);
                }
                float p[16];
#pragma unroll
                for (int i = 0; i < 16; ++i) { p[i] = __builtin_amdgcn_exp2f(acc[i]); rs[s] += p[i]; }
#pragma unroll
                for (int s2 = 0; s2 < 2; ++s2)
#pragma unroll
                    for (int j = 0; j < 4; ++j) pf[kt][s2].u[j] = cvt_pk_bf16(p[s2 * 8 + j * 2], p[s2 * 8 + j * 2 + 1]);
            }
#pragma unroll
            for (int d = 0; d < 2; ++d)
#pragma unroll
                for (int kt = 0; kt < 2; ++kt)
#pragma unroll
                    for (int s2 = 0; s2 < 2; ++s2) O[s][d] = mfma32(vf[d][kt * 2 + s2], pf[kt][s2].v, O[s][d]);
            __builtin_amdgcn_sched_barrier(0);
        }
    }
    const float r0 = rs[0] + xor32(rs[0]), r1 = rs[1] + xor32(rs[1]);
    const float c0 = 1.f / r0, c1 = lam / r1;
    float ss = 0.f;
#pragma unroll
    for (int d = 0; d < 2; ++d)
#pragma unroll
        for (int i = 0; i < 16; ++i) { const float o = O[0][d][i] * c0 - O[1][d][i] * c1; O[0][d][i] = o; ss += o * o; }
    ss += xor32(ss);
    const float rinv = rsqrtf(ss * (1.f / 64.f) + EPS) * (1.f - li);
    const int t2 = opaque_tid();
    const int hq2 = (t2 >> 5) & 1;
    u16* op = outp + (size_t)((t2 >> 6) * 32 + (t2 & 31)) * D;
#pragma unroll
    for (int d = 0; d < 2; ++d)
#pragma unroll
        for (int g4 = 0; g4 < 4; ++g4) {
            const int dv0 = d * 32 + 8 * g4 + 4 * hq2;
            const float4 gs = *(const float4*)(gsub + dv0);
            uint2 o;
            o.x = pack2(O[0][d][g4 * 4 + 0] * rinv * gs.x, O[0][d][g4 * 4 + 1] * rinv * gs.y);
            o.y = pack2(O[0][d][g4 * 4 + 2] * rinv * gs.z, O[0][d][g4 * 4 + 3] * rinv * gs.w);
            *(uint2*)(op + dv0) = o;
        }
}
DEV void phase_attnA(const Params& P, int l, int bid, int nb, char* lds) {
    char* const wsb = opaque_ptr(P.ws);
    const int tidx = opaque_tid();
    const bool last = (l == 1);
    const float lam = ((const float*)(wsb + OFF_MISC))[l];
    const float li = lam_init_of(l);
    const float* gsub = P.in[I_AGSUB] + l * 64;
    const int nlat = NBATCH * 6 * 16;
    const int nctx = last ? 0 : NBATCH * 6;
    for (int u = bid; u < nlat + nctx; u += nb) {
        if (u < nlat) {
            const int ux = u & 7, ui = (u >> 3);
            const int pair = ux * 6 + (ui >> 4), qb = ui & 15;
            const int b = pair / 6, h = pair % 6;
            const u16* q0p = (const u16*)(wsb + OFF_QA) + ((size_t)((b * 6 + h) * 2 + 0) * SEQ + qb * 256) * 32;
            const u16* q1p = (const u16*)(wsb + OFF_QA) + ((size_t)((b * 6 + h) * 2 + 1) * SEQ + qb * 256) * 32;
            attnA_unit(q0p, q1p, (const u16*)(wsb + OFF_KA) + (size_t)(b * 6 + h) * NKEY * 64, (const u16*)(wsb + OFF_VAT) + (size_t)(b * 6 + h) * 64 * NKEY,
                       0, NKEY / 64, (u16*)(wsb + OFF_HBUF) + (size_t)(b * SEQ + qb * 256) * D + h * 64, lam, li, gsub, lds, tidx);
        } else {
            const int j = u - nlat, b = j / 6, h = j % 6;
            const u16* q0p = (const u16*)(wsb + OFF_QAC) + ((size_t)((b * 6 + h) * 2 + 0) * LCTX) * 32;
            const u16* q1p = (const u16*)(wsb + OFF_QAC) + ((size_t)((b * 6 + h) * 2 + 1) * LCTX) * 32;
            attnA_unit(q0p, q1p, (const u16*)(wsb + OFF_KA) + (size_t)(b * 6 + h) * NKEY * 64, (const u16*)(wsb + OFF_VAT) + (size_t)(b * 6 + h) * 64 * NKEY,
                       SEQ / 64, NKEY / 64, (u16*)(wsb + OFF_HBUF) + (size_t)(TL + b * LCTX) * D + h * 64, lam, li, gsub, lds, tidx);
        }
    }
}

DEV void phase_attnN(const Params& P, int l, int bid, int nb, char* lds) {
    char* const wsb = opaque_ptr(P.ws);
    const bool last = (l == 1);
    float* part = (float*)lds;
    float* rpbs = (float*)(lds + 8 * 33 * 64 * 4);
    const int nlat = NBATCH * 6 * 16;
    const int nctx = last ? 0 : NBATCH * 6;
    for (int u = bid; u < nlat + nctx; u += nb) {
        const int tidx = opaque_tid();
        const int w = tidx >> 6, lane = tidx & 63, rl = lane & 31, hq = lane >> 5;
        if (u < nlat) {
            const int ux = u & 7, ui = (u >> 3);
            const int pair = ux * 6 + (ui >> 4), rg = ui & 15;
            const int b = pair / 6, h = pair % 6;
            const int r = rg * 4 + (w >> 1), qt = w & 1;
            const int qc = qt * 32 + rl;
            float* rpbs = (float*)(lds + 8 * KV_TILE);
            __syncthreads();
            if (tidx < 480) { const int dr_ = tidx >> 5, dc_ = tidx & 31; rpbs[tidx] = dc_ < 31 ? P.in[I_NRPB][((size_t)l * 6 + h) * 465 + dr_ * 31 + dc_] * LOG2E : -1e30f; }
            const u16* qp = (const u16*)(wsb + OFF_QN) + ((size_t)(b * 6 + h) * SEQ + r * 64 + qc) * 64;
            FragU qf[4];
#pragma unroll
            for (int ks = 0; ks < 4; ++ks) qf[ks].q = *(const uint4*)(qp + ks * 16 + hq * 8);
            const u16* kb = (const u16*)(wsb + OFF_KN) + (size_t)(b * 6 + h) * NKEY * 64;
            const u16* vb = (const u16*)(wsb + OFF_VNT) + (size_t)(b * 6 + h) * 64 * NKEY;
            const int r0 = min(max(r - 4, 0), 56), cs = min(max(qc - 8, 0), 48);
            const int r0min = min(max(rg * 4 - 4, 0), 56), r0max = min(max(rg * 4 - 1, 0), 56);
            const int nloc = r0max - r0min + 8, nst = nloc + 4;
            int bidx[2][16];
#pragma unroll
            for (int ct = 0; ct < 2; ++ct)
#pragma unroll
                for (int i2 = 0; i2 < 16; ++i2) {
                    const int kc = ct * 32 + (i2 & 3) + 8 * (i2 >> 2) + 4 * hq;
                    const bool valid = (kc >= cs) && (kc < cs + 16);
                    bidx[ct][i2] = (valid ? kc - qc + 15 : 31) * 4;
                }
            f32x16 O[2];
#pragma unroll
            for (int d = 0; d < 2; ++d)
#pragma unroll
                for (int i = 0; i < 16; ++i) O[d][i] = 0.f;
            float rs = 0.f;
            const int srow = tidx >> 3, schunk = tidx & 7;
            const int soff = srow * KV_ROW + schunk * 16;
#define NA_SKEY(st) ((st) < nloc ? (r0min + (st)) * 64 : SEQ + ((st) - nloc) * 64)
            u32x4 kreg0, vreg0, kreg1, vreg1;
            {
                const int k0_ = NA_SKEY(0), k1_ = NA_SKEY(1);
                kreg0 = *(const u32x4*)(kb + (size_t)(k0_ + srow) * 64 + schunk * 8); vreg0 = *(const u32x4*)(vb + (size_t)srow * NKEY + k0_ + schunk * 8);
                kreg1 = *(const u32x4*)(kb + (size_t)(k1_ + srow) * 64 + schunk * 8); vreg1 = *(const u32x4*)(vb + (size_t)srow * NKEY + k1_ + schunk * 8);
            }
            __syncthreads();
            for (int st = 0; st < nst; st += 2) {
                char* St = lds + ((st >> 1) & 1) * (4 * KV_TILE);
                *(u32x4*)(St + soff) = kreg0;
                *(u32x4*)(St + KV_TILE + soff) = vreg0;
                *(u32x4*)(St + 2 * KV_TILE + soff) = kreg1;
                *(u32x4*)(St + 3 * KV_TILE + soff) = vreg1;
                __syncthreads();
                if (st + 2 < nst) {
                    const int k0_ = NA_SKEY(st + 2), k1_ = NA_SKEY(st + 3 < nst ? st + 3 : st + 2);
                    kreg0 = *(const u32x4*)(kb + (size_t)(k0_ + srow) * 64 + schunk * 8); vreg0 = *(const u32x4*)(vb + (size_t)srow * NKEY + k0_ + schunk * 8);
                    kreg1 = *(const u32x4*)(kb + (size_t)(k1_ + srow) * 64 + schunk * 8); vreg1 = *(const u32x4*)(vb + (size_t)srow * NKEY + k1_ + schunk * 8);
                }
#pragma unroll 1
                for (int h2 = 0; h2 < 2; ++h2) {
                    const int sc = st + h2;
                    if (sc >= nst) break;
                    const char* Ks = St + h2 * 2 * KV_TILE;
                    const char* Vs = Ks + KV_TILE;
                    const bool local = sc < nloc;
                    const int kr = r0min + sc;
                    if (!local || (kr >= r0 && kr < r0 + 8)) {
                        const char* rrow = (const char*)rpbs + (kr - r + 7) * 128;
#pragma unroll
                        for (int ct = 0; ct < 2; ++ct) {
                            f32x16 acc;
#pragma unroll
                            for (int i2 = 0; i2 < 16; ++i2) acc[i2] = 0.f;
#pragma unroll
                            for (int ks = 0; ks < 4; ++ks) {
                                const bf16x8 kf = *(const bf16x8*)(Ks + (ct * 32 + rl) * KV_ROW + ks * 32 + hq * 16);
                                acc = mfma32(kf, qf[ks].v, acc);
                            }
                            float p[16];
                            if (local) {
#pragma unroll
                                for (int i2 = 0; i2 < 16; ++i2) { const float v = __builtin_amdgcn_exp2f(acc[i2] + *(const float*)(rrow + bidx[ct][i2])); p[i2] = v; rs += v; }
                            } else {
#pragma unroll
                                for (int i2 = 0; i2 < 16; ++i2) { const float v = __builtin_amdgcn_exp2f(acc[i2]); p[i2] = v; rs += v; }
                            }
                            FragU pf[2];
#pragma unroll
                            for (int s2 = 0; s2 < 2; ++s2)
#pragma unroll
                                for (int j2 = 0; j2 < 4; ++j2) pf[s2].u[j2] = cvt_pk_bf16(p[s2 * 8 + j2 * 2], p[s2 * 8 + j2 * 2 + 1]);
#pragma unroll
                            for (int d = 0; d < 2; ++d)
#pragma unroll
                                for (int s2 = 0; s2 < 2; ++s2) {
                                    const bf16x8 vf = *(const bf16x8*)(Vs + (d * 32 + rl) * KV_ROW + ((ct * 2 + s2) * 16 + hq * 8) * 2);
                                    O[d] = mfma32(vf, pf[s2].v, O[d]);
                                }
                        }
                    }
                }
            }
#undef NA_SKEY
            rs += xor32(rs);
            const float inv = 1.f / rs;
            u16* op = (u16*)(wsb + OFF_HBUF) + (size_t)(b * SEQ + r * 64 + qc) * D + 640 + h * 64;
#pragma unroll
            for (int d = 0; d < 2; ++d)
#pragma unroll
                for (int g4 = 0; g4 < 4; ++g4) {
                    const int dv0 = d * 32 + 8 * g4 + 4 * hq;
                    uint2 o;
                    o.x = pack2(O[d][g4 * 4 + 0] * inv, O[d][g4 * 4 + 1] * inv);
                    o.y = pack2(O[d][g4 * 4 + 2] * inv, O[d][g4 * 4 + 3] * inv);
                    *(uint2*)(op + dv0) = o;
                }
        } else {
            const int j = u - nlat, b = j / 6, h = j % 6;
            const u16* qp = (const u16*)(wsb + OFF_QNC) + ((size_t)(b * 6 + h) * LCTX + w * 32 + rl) * 64;
            FragU qf[4];
#pragma unroll
            for (int ks = 0; ks < 4; ++ks) qf[ks].q = *(const uint4*)(qp + ks * 16 + hq * 8);
            const u16* kb = (const u16*)(wsb + OFF_KN) + (size_t)(b * 6 + h) * NKEY * 64;
            const u16* vb = (const u16*)(wsb + OFF_VNT) + (size_t)(b * 6 + h) * 64 * NKEY;
            f32x16 O[2];
#pragma unroll
            for (int d = 0; d < 2; ++d)
#pragma unroll
                for (int i = 0; i < 16; ++i) O[d][i] = 0.f;
            float rs = 0.f;
            for (int tile = 0; tile < 8; ++tile) {
                const int key0 = SEQ + tile * 32;
                f32x16 acc;
#pragma unroll
                for (int i = 0; i < 16; ++i) acc[i] = 0.f;
#pragma unroll
                for (int ks = 0; ks < 4; ++ks) {
                    FragU kf; kf.q = *(const uint4*)(kb + (size_t)(key0 + rl) * 64 + ks * 16 + hq * 8);
                    acc = mfma32(kf.v, qf[ks].v, acc);
                }
                float p[16];
#pragma unroll
                for (int i = 0; i < 16; ++i) { p[i] = __builtin_amdgcn_exp2f(acc[i]); rs += p[i]; }
                FragU pf[2];
#pragma unroll
                for (int s2 = 0; s2 < 2; ++s2)
#pragma unroll
                    for (int jj = 0; jj < 4; ++jj) pf[s2].u[jj] = cvt_pk_bf16(p[s2 * 8 + jj * 2], p[s2 * 8 + jj * 2 + 1]);
#pragma unroll
                for (int d = 0; d < 2; ++d)
#pragma unroll
                    for (int s2 = 0; s2 < 2; ++s2) {
                        FragU vf; vf.q = *(const uint4*)(vb + (size_t)(d * 32 + rl) * NKEY + key0 + s2 * 16 + hq * 8);
                        O[d] = mfma32(vf.v, pf[s2].v, O[d]);
                    }
            }
            rs += xor32(rs);
            const float inv = 1.f / rs;
            u16* op = (u16*)(wsb + OFF_HBUF) + (size_t)(TL + b * LCTX + w * 32 + rl) * D + 640 + h * 64;
#pragma unroll
            for (int d = 0; d < 2; ++d)
#pragma unroll
                for (int g4 = 0; g4 < 4; ++g4) {
                    const int dv0 = d * 32 + 8 * g4 + 4 * hq;
                    uint2 o;
                    o.x = pack2(O[d][g4 * 4 + 0] * inv, O[d][g4 * 4 + 1] * inv);
                    o.y = pack2(O[d][g4 * 4 + 2] * inv, O[d][g4 * 4 + 3] * inv);
                    *(uint2*)(op + dv0) = o;
                }
        }
    }
}


DEV float2 cmul(float2 a, float2 b) { return make_float2(a.x * b.x - a.y * b.y, a.x * b.y + a.y * b.x); }
DEV void s5_kf_init(const Params& P, int bid, int nb, char* lds) {
    char* const wsb = opaque_ptr(P.ws);
    const int tidx = opaque_tid();
    float2* pw = (float2*)lds;
    float2* bb = pw + 8 * 64;
    float2* cc = bb + 64 * 16;
    float* KF = (float*)(wsb + OFF_KF);
    for (int job = bid; job < 256; job += nb) {
        const int l = job >> 7, g = (job >> 3) & 15, k = (job >> 2) & 1, dq = job & 3;
        const size_t pg = (size_t)(l * 2 + k) * 16 + g;
        __syncthreads();
        {
            const int d = dq * 8 + (tidx >> 6), n = tidx & 63;
            const float are = P.in[I_S5ARE][pg * 64 + n], aim = P.in[I_S5AIM][pg * 64 + n];
            const float dt = expf(P.in[I_S5LDT][pg]);
            const float mag = expf(are * dt * (float)d), ang = aim * dt * (float)d;
            pw[tidx] = make_float2(mag * cosf(ang), mag * sinf(ang));
        }
        for (int i = tidx; i < 64 * 16; i += NTHREADS) {
            const int n = i >> 4, p = i & 15;
            const float are = P.in[I_S5ARE][pg * 64 + n], aim = P.in[I_S5AIM][pg * 64 + n];
            const float dt = expf(P.in[I_S5LDT][pg]);
            const float mag = expf(are * dt);
            const float nr = mag * cosf(aim * dt) - 1.f, ni = mag * sinf(aim * dt);
            const float den = are * are + aim * aim;
            const float2 f = make_float2((nr * are + ni * aim) / den, (ni * are - nr * aim) / den);
            bb[i] = cmul(f, make_float2(P.in[I_S5BRE][(pg * 64 + n) * 16 + p], P.in[I_S5BIM][(pg * 64 + n) * 16 + p]));
        }
        for (int i = tidx; i < 16 * 64; i += NTHREADS) {
            const int p = i >> 6, n = i & 63;
            cc[i] = make_float2(P.in[I_S5CRE][(pg * 16 + p) * 64 + n], P.in[I_S5CIM][(pg * 16 + p) * 64 + n]);
        }
        __syncthreads();
        for (int i = tidx; i < 8 * 256; i += NTHREADS) {
            const int dl = i >> 8, p = (i >> 4) & 15, q = i & 15;
            float acc = 0.f;
            for (int n = 0; n < 64; ++n) {
                const float2 t = cmul(cc[p * 64 + n], pw[dl * 64 + n]);
                const float2 b2 = bb[n * 16 + q];
                acc += t.x * b2.x - t.y * b2.y;
            }
            KF[((pg * 32) + dq * 8 + dl) * 256 + p * 16 + q] = acc;
        }
    }
}
DEV void s5_gen(const Params& P, int l, int bid, int nb, char* lds) {
    char* const wsb = opaque_ptr(P.ws);
    const int tidx = opaque_tid();
    float2* pw = (float2*)lds;
    float2* bb = pw + 2 * 33 * 64;
    float2* cc = bb + 2 * 64 * 16;
    u16* M1 = (u16*)(wsb + OFF_M1);
    u16* M3 = (u16*)(wsb + OFF_M3);
    const float* KF = (const float*)(wsb + OFF_KF);
    for (int job = bid; job < 256; job += nb) {
        const int g = job >> 4, part = job & 15;
        __syncthreads();
        for (int i = tidx; i < 2 * 33 * 64; i += NTHREADS) {
            const int k = i / (33 * 64), d = (i >> 6) % 33, n = i & 63;
            const size_t pg = (size_t)(l * 2 + k) * 16 + g;
            const float are = P.in[I_S5ARE][pg * 64 + n], aim = P.in[I_S5AIM][pg * 64 + n];
            const float dt = expf(P.in[I_S5LDT][pg]);
            const float mag = expf(are * dt * (float)d), ang = aim * dt * (float)d;
            pw[i] = make_float2(mag * cosf(ang), mag * sinf(ang));
        }
        for (int i = tidx; i < 2 * 64 * 16; i += NTHREADS) {
            const int k = i >> 10, n = (i >> 4) & 63, p = i & 15;
            const size_t pg = (size_t)(l * 2 + k) * 16 + g;
            const float are = P.in[I_S5ARE][pg * 64 + n], aim = P.in[I_S5AIM][pg * 64 + n];
            const float dt = expf(P.in[I_S5LDT][pg]);
            const float mag = expf(are * dt);
            const float nr = mag * cosf(aim * dt) - 1.f, ni = mag * sinf(aim * dt);
            const float den = are * are + aim * aim;
            const float2 f = make_float2((nr * are + ni * aim) / den, (ni * are - nr * aim) / den);
            bb[i] = cmul(f, make_float2(P.in[I_S5BRE][(pg * 64 + n) * 16 + p], P.in[I_S5BIM][(pg * 64 + n) * 16 + p]));
        }
        for (int i = tidx; i < 2 * 16 * 64; i += NTHREADS) {
            const int k = i >> 10, p = (i >> 6) & 15, n = i & 63;
            const size_t pg = (size_t)(l * 2 + k) * 16 + g;
            cc[i] = make_float2(P.in[I_S5CRE][(pg * 16 + p) * 64 + n], P.in[I_S5CIM][(pg * 16 + p) * 64 + n]);
        }
        __syncthreads();
        const float* kf0 = KF + ((size_t)(l * 2 + 0) * 16 + g) * 32 * 256;
        const float* kf1 = KF + ((size_t)(l * 2 + 1) * 16 + g) * 32 * 256;
        for (int idx = tidx; idx < 32 * 96; idx += NTHREADS) {
            const int row = part * 32 + idx / 96, c8 = (idx % 96) * 8;
            const int tau = row >> 4, p = row & 15;
            float v[8];
#pragma unroll
            for (int j = 0; j < 8; ++j) {
                const int col = c8 + j;
                if (col < 256) {
                    const int k = col >> 7, im = (col >> 6) & 1, n = col & 63;
                    const int d = (k == 0) ? tau + 1 : 32 - tau;
                    const float2 t = cmul(cc[(k * 16 + p) * 64 + n], pw[(k * 33 + d) * 64 + n]);
                    v[j] = im ? -t.y : t.x;
                } else {
                    const int sg = (col - 256) >> 4, q = col & 15;
                    float x = 0.f;
                    if (sg <= tau) x += kf0[(tau - sg) * 256 + p * 16 + q];
                    if (sg >= tau) x += kf1[(sg - tau) * 256 + p * 16 + q];
                    v[j] = x;
                }
            }
            *(uint4*)(M3 + ((size_t)g * 512 + row) * 768 + c8) = pack8(v);
        }
        for (int idx = tidx; idx < 16 * 64; idx += NTHREADS) {
            const int row = part * 16 + (idx >> 6), c8 = (idx & 63) * 8;
            const int k = row >> 7, im = (row >> 6) & 1, n = row & 63;
            float v[8];
#pragma unroll
            for (int j = 0; j < 8; ++j) {
                const int col = c8 + j, tau = col >> 4, p = col & 15;
                const int d = (k == 0) ? 31 - tau : tau;
                const float2 t = cmul(pw[(k * 33 + d) * 64 + n], bb[(k * 64 + n) * 16 + p]);
                v[j] = im ? t.y : t.x;
            }
            *(uint4*)(M1 + ((size_t)g * 256 + row) * 512 + c8) = pack8(v);
        }
    }
}
DEV void phase_s5_E(const Params& P, int l, int bid, int nb, char* lds) {
    char* const wsb = opaque_ptr(P.ws);
    const u16* X = (const u16*)(wsb + OFF_XS5);
    for (int i = bid; i < 80; i += nb) {
        const int g = i / 5, row0 = (i % 5) * 256;
        gemm_tile_core(X, [=](int r) -> u32 { return (u32)(g * 1088 + min(row0 + r, 1087)) * 768u + 256u; }, (const u16*)(wsb + OFF_M1) + (size_t)g * 256 * 512, 512, lds);
        const u16* Cs = (const u16*)lds;
        const int te = opaque_tid();
        const int r = te >> 1, ch = (te & 1) * 128;
        const int row = row0 + r;
        if (row < 1088) {
            u16* dst = (u16*)(wsb + OFF_ES5) + ((size_t)g * 1088 + row) * 256 + ch;
#pragma unroll
            for (int c = 0; c < 128; c += 8) *(uint4*)(dst + c) = *(const uint4*)(Cs + r * CS_STRIDE + ch + c);
        }
    }
}
DEV void phase_s5_carry(const Params& P, int l, int bid, int nb) {
    char* const wsb = opaque_ptr(P.ws);
    const int tidx = opaque_tid();
    if (tidx < 64) {
        const int n = tidx;
        for (int job = bid; job < 256; job += nb) {
            const int g = job >> 4, b = (job >> 1) & 7, dir = job & 1;
            const size_t pg = (size_t)(l * 2 + dir) * 16 + g;
            const float are = P.in[I_S5ARE][pg * 64 + n], aim = P.in[I_S5AIM][pg * 64 + n];
            const float dt = expf(P.in[I_S5LDT][pg]);
            const float mag = expf(are * dt * 32.f), ang = aim * dt * 32.f;
            const float ar = mag * cosf(ang), ai = mag * sinf(ang);
            const u16* E = (const u16*)(wsb + OFF_ES5) + ((size_t)g * 1088 + b * 136) * 256 + dir * 128 + n;
            u16* X = (u16*)(wsb + OFF_XS5) + ((size_t)g * 1088 + b * 136) * 768 + dir * 128 + n;
            float sr = 0.f, si = 0.f;
            for (int st0 = 0; st0 < 136; st0 += 34) {
                float er[34], ei[34];
#pragma unroll
                for (int j = 0; j < 34; ++j) {
                    const int st = st0 + j;
                    const int row = (dir == 0) ? st : (st < 8 ? 7 - st : 143 - st);
                    er[j] = bf2f(E[(size_t)row * 256]);
                    ei[j] = bf2f(E[(size_t)row * 256 + 64]);
                }
#pragma unroll
                for (int j = 0; j < 34; ++j) {
                    const int st = st0 + j;
                    const int row = (dir == 0) ? st : (st < 8 ? 7 - st : 143 - st);
                    X[(size_t)row * 768] = f2bf(sr);
                    X[(size_t)row * 768 + 64] = f2bf(si);
                    const float nr = ar * sr - ai * si + er[j];
                    const float ni = ar * si + ai * sr + ei[j];
                    sr = nr; si = ni;
                }
            }
        }
    }
}
DEV void phase_s5_Y(const Params& P, int l, int bid, int nb, char* lds) {
    char* const wsb = opaque_ptr(P.ws);
    const bool last = (l == 1);
    const u16* X = (const u16*)(wsb + OFF_XS5);
    for (int i = bid; i < 160; i += nb) {
        const int g = i / 10, row0 = ((i % 10) >> 1) * 256, nt_ = i & 1;
        gemm_tile_core(X, [=](int r) -> u32 { return (u32)(g * 1088 + min(row0 + r, 1087)) * 768u; }, (const u16*)(wsb + OFF_M3) + ((size_t)g * 512 + nt_ * 256) * 768, 768, lds);
        const u16* Cs = (const u16*)lds;
        const int te = opaque_tid();
        const int r = te >> 1, hf = te & 1;
        const int row = row0 + r;
        if (row < 1088) {
            const int b = row / 136, fch = row % 136;
            if (!(last && fch < 8)) {
                const float* dsk = P.in[I_S5D] + l * 256 + g * 16;
                float dk[16];
#pragma unroll
                for (int p = 0; p < 16; ++p) dk[p] = dsk[p];
#pragma unroll 2
                for (int tl = 0; tl < 8; ++tl) {
                    const int tau = nt_ * 16 + hf * 8 + tl;
                    const int tok = fch < 8 ? TL + b * LCTX + fch * 32 + tau : b * SEQ + (fch - 8) * 32 + tau;
                    float y[16], u[16];
                    unpack8(*(const uint4*)(Cs + r * CS_STRIDE + hf * 128 + tl * 16), y);
                    unpack8(*(const uint4*)(Cs + r * CS_STRIDE + hf * 128 + tl * 16 + 8), y + 8);
                    const u16* up = (const u16*)(wsb + OFF_U) + (size_t)tok * 256 + g * 16;
                    unpack8(*(const uint4*)up, u); unpack8(*(const uint4*)(up + 8), u + 8);
#pragma unroll
                    for (int p = 0; p < 16; ++p) y[p] = gelu_tanh(y[p] + dk[p] * u[p]);
                    u16* gp = (u16*)(wsb + OFF_GBUF) + (size_t)tok * 256 + g * 16;
                    *(uint4*)gp = pack8(y); *(uint4*)(gp + 8) = pack8(y + 8);
                }
            }
        }
    }
}
DEV void phase_s5_glu(const Params& P, int l, int bid, int nb, char* lds) {
    char* const wsb = opaque_ptr(P.ws);
    const bool last = (l == 1);
    const int nmt = last ? 128 : 136;
    const u16* G = (const u16*)(wsb + OFF_GBUF);
    const float* bg = P.in[I_S5BGLU] + l * 256;
    const int boff = (!last && nb == NBLK) ? 48 : 0;
    for (int mt = (bid >= boff ? bid - boff : bid + nb - boff); mt < nmt; mt += nb) {
        const int row0 = mt * 256;
        gemm_tile_core(G, [=](int r) -> u32 { return (u32)(row0 + r) * 256u; }, (const u16*)(wsb + OFF_WGLU) + (size_t)l * 256 * 256, 256, lds);
        const u16* Cs = (const u16*)lds;
        const int te = opaque_tid();
        const int r = te >> 1, ch = (te & 1) * 128;
        const int tok = row0 + r;
        u16* dst = (u16*)(wsb + OFF_HBUF) + (size_t)tok * D + 384 + ch;
#pragma unroll 2
        for (int c = 0; c < 128; c += 8) {
            float z[8], gv[8];
            unpack8(*(const uint4*)(Cs + r * CS_STRIDE + ch + c), z);
            unpack8(*(const uint4*)(G + (size_t)tok * 256 + ch + c), gv);
#pragma unroll
            for (int j = 0; j < 8; ++j) z[j] = gv[j] * sigmoid_f(z[j] + bg[ch + c + j]);
            *(uint4*)(dst + c) = pack8(z);
        }
    }
}


DEV void phase_outproj(const Params& P, int l, int bid, int nb, char* lds) {
    char* const wsb = opaque_ptr(P.ws);
    const bool last = (l == 1);
    const u16* A = (const u16*)(wsb + OFF_HBUF);
    const u16* W = (const u16*)(wsb + OFF_WOUT) + (size_t)l * D * D;
    const float* mod = (const float*)(wsb + OFF_MOD) + (size_t)l * 9 * 6144;
    const int nmt = last ? 128 : 136;
    for (int i = bid; i < nmt * 4; i += nb) {
        const int mt = i >> 2, nt_ = i & 3;
        const int row0 = mt * 256;
        gemm_tile_core(A, [=](int r) -> u32 { return (u32)(row0 + r) * D; }, W + (size_t)nt_ * 256 * D, D, lds);
        const u16* Cs = (const u16*)lds;
        const int te = opaque_tid();
        const int r = te >> 1, ch = (te & 1) * 128;
        const int tok = row0 + r;
        const float* xp = xrow_prev(P, l, tok) + nt_ * 256 + ch;
        float* xo = xrow_cur(P, tok) + nt_ * 256 + ch;
        const float* gt = mod + (size_t)tok_mb(tok) * 6144 + 2048 + nt_ * 256 + ch;
#pragma unroll 4
        for (int c = 0; c < 128; c += 8) {
            float y[8]; unpack8(*(const uint4*)(Cs + r * CS_STRIDE + ch + c), y);
            const float4 x0 = *(const float4*)(xp + c), x1 = *(const float4*)(xp + c + 4);
            const float4 g0 = *(const float4*)(gt + c), g1 = *(const float4*)(gt + c + 4);
            float4 o0, o1;
            o0.x = x0.x + g0.x * y[0]; o0.y = x0.y + g0.y * y[1]; o0.z = x0.z + g0.z * y[2]; o0.w = x0.w + g0.w * y[3];
            o1.x = x1.x + g1.x * y[4]; o1.y = x1.y + g1.y * y[5]; o1.z = x1.z + g1.z * y[6]; o1.w = x1.w + g1.w * y[7];
            *(float4*)(xo + c) = o0; *(float4*)(xo + c + 4) = o1;
        }
    }
    if (!last) {
        if (nb == NBLK && bid >= OUTPROJ_BUSY0) conv_jobs(P, l, CONV_J1_0 + bid - OUTPROJ_BUSY0, CONV_J2_0, NBLK - OUTPROJ_BUSY0, lds);
        else if (nb != NBLK) conv_jobs(P, l, CONV_J1_0 + bid, CONV_J2_0, nb, lds);
    }
}

#define SPLIT8_BF16(x0, x1, hi, lo) do { u32x4 _h, _l; \
        _Pragma("unroll") for (int _p = 0; _p < 4; ++_p) { \
            const float _a = _p < 2 ? (x0)[2 * _p] : (x1)[2 * _p - 4], _b = _p < 2 ? (x0)[2 * _p + 1] : (x1)[2 * _p - 3]; \
            const u32 _hp = cvt_pk_bf16(_a, _b); \
            _h[_p] = _hp; _l[_p] = cvt_pk_bf16(_a - __uint_as_float(_hp << 16), _b - __uint_as_float(_hp & 0xFFFF0000u)); \
            __builtin_amdgcn_sched_barrier(0); } \
        hi = __builtin_bit_cast(bf16x8, _h); lo = __builtin_bit_cast(bf16x8, _l); } while (0)
DEV void phase_norm2_router(const Params& P, int l, int bid, int nb, char* lds) {
    char* const wsb = opaque_ptr(P.ws);
    const int tidx = opaque_tid();
    const bool last = (l == 1);
    const int ntok = last ? TL : TT;
    const int tpb = ntok / NBLK;
    const int w = tidx >> 6, lane = tidx & 63;
    constexpr int HLS = 1028;
    float* hl = (float*)lds;
    float* part = hl + 16 * HLS;
    int* ents = (int*)(part + 8 * 16 * 64);
    float* modl = (float*)(ents + 1088);
    const float* mod = (const float*)(wsb + OFF_MOD) + (size_t)l * 9 * 6144;
    const float* g = P.in[I_GFFN] + l * D;
    const float* wr = P.in[I_WROUTER] + (size_t)l * D * NEXP;
    const float eb = P.in[I_EBIAS][l * NEXP + lane];
    u16* hb = (u16*)(wsb + OFF_HBUF);
    int* tok_e = (int*)(wsb + OFF_TOKE);
    float* tok_w = (float*)(wsb + OFF_TOKW);
    for (int blk = bid; blk < NBLK; blk += nb) {
        const int t0 = blk * tpb;
        bf16x8 whi[4][4], wlo[4][4];
        {
            const float* qw = wr + (size_t)(w * 128 + 8 * (lane >> 4)) * NEXP + (lane & 15);
#pragma unroll
            for (int ks = 0; ks < 4; ++ks) {
                asm volatile("" : "+v"(qw));
#pragma unroll
                for (int tl4 = 0; tl4 < 4; ++tl4) {
                    const f32x4 f0 = {qw[0 * NEXP + tl4 * 16], qw[1 * NEXP + tl4 * 16], qw[2 * NEXP + tl4 * 16], qw[3 * NEXP + tl4 * 16]};
                    const f32x4 f1 = {qw[4 * NEXP + tl4 * 16], qw[5 * NEXP + tl4 * 16], qw[6 * NEXP + tl4 * 16], qw[7 * NEXP + tl4 * 16]};
                    SPLIT8_BF16(f0, f1, whi[ks][tl4], wlo[ks][tl4]);
                }
                __builtin_amdgcn_sched_barrier(0);
                qw += 32 * NEXP;
            }
        }
        const int mb0 = tok_mb(t0), mb1 = tok_mb(t0 + tpb - 1);
        for (int i = tidx; i < 2048; i += NTHREADS) {
            const int sl = i >> 10, c = i & 1023;
            const float* mrow = mod + (size_t)(sl ? mb1 : mb0) * 6144;
            modl[sl * 2048 + c] = g[c] * (1.f + mrow[4096 + c]);
            modl[sl * 2048 + 1024 + c] = mrow[3072 + c];
        }
        __syncthreads();
        f32x4 xv[2][4];
#pragma unroll
        for (int j = 0; j < 2; ++j) {
            const int tl = 2 * w + j;
            const float* xr = xrow_cur(P, t0 + (tl < tpb ? tl : 0));
#pragma unroll
            for (int i = 0; i < 4; ++i) xv[j][i] = *(const f32x4*)(xr + lane * 4 + i * 256);
        }
        for (int gcur = 0; gcur < tpb + 16; gcur += 16) {
            if (gcur > 0) {
                const int grp = gcur - 16;
            __syncthreads();
            {
                f32x4 accm[4];
#pragma unroll
                for (int tl4 = 0; tl4 < 4; ++tl4) accm[tl4] = (f32x4){0.f, 0.f, 0.f, 0.f};
                const float* hp = hl + (lane & 15) * HLS + w * 128 + 8 * (lane >> 4);
#pragma unroll
                for (int ks = 0; ks < 4; ++ks) {
                    const f32x4 x0 = *(const f32x4*)(hp + ks * 32), x1 = *(const f32x4*)(hp + ks * 32 + 4);
                    bf16x8 ahi, alo;
                    SPLIT8_BF16(x0, x1, ahi, alo);
#pragma unroll
                    for (int tl4 = 0; tl4 < 4; ++tl4) {
                        accm[tl4] = __builtin_amdgcn_mfma_f32_16x16x32_bf16(alo, whi[ks][tl4], accm[tl4], 0, 0, 0);
                        accm[tl4] = __builtin_amdgcn_mfma_f32_16x16x32_bf16(ahi, wlo[ks][tl4], accm[tl4], 0, 0, 0);
                        accm[tl4] = __builtin_amdgcn_mfma_f32_16x16x32_bf16(ahi, whi[ks][tl4], accm[tl4], 0, 0, 0);
                    }
                    __builtin_amdgcn_sched_barrier(0);
                }
#pragma unroll
                for (int tl4 = 0; tl4 < 4; ++tl4)
#pragma unroll
                    for (int r4 = 0; r4 < 4; ++r4) part[(w * 16 + 4 * (lane >> 4) + r4) * 64 + tl4 * 16 + (lane & 15)] = accm[tl4][r4];
            }
            __syncthreads();
#pragma unroll 1
            for (int j = 0; j < 2; ++j) {
                const int tl = 2 * w + j;
                if (grp + tl < tpb) {
                    const int tk = t0 + grp + tl;
                    float a = 0.f;
#pragma unroll
                    for (int ww = 0; ww < 8; ++ww) a += part[(ww * 16 + tl) * 64 + lane];
                    const float sc = sigmoid_f(a);
                    const float bi = sc + eb;
                    const float m1 = max8(bi);
                    const unsigned g8 = (unsigned)(__ballot(bi == m1) >> (lane & ~7)) & 0xFFu;
                    const int holder = (lane & ~7) + __builtin_ctz(g8);
                    float gs = m1 + max8(lane == holder ? -INFINITY : bi);
                    const int gi = lane >> 3; int grank = 0;
#pragma unroll
                    for (int jj = 0; jj < 8; ++jj) { const float o = __int_as_float(__builtin_amdgcn_readlane(__float_as_int(gs), jj * 8)); grank += (o > gs || (o == gs && jj < gi)) ? 1 : 0; }
                    const bool gsel = grank < 4;
                    const float val = gsel ? bi : -INFINITY;
                    int erank = 0;
#pragma unroll 8
                    for (int jj = 0; jj < 64; ++jj) { const float o = __int_as_float(__builtin_amdgcn_readlane(__float_as_int(val), jj)); erank += (o > val || (o == val && jj < lane)) ? 1 : 0; }
                    const bool sel = gsel && erank < 8;
                    const float wsum = wave_sum(sel ? sc : 0.f);
                    if (sel) { tok_e[(size_t)tk * 8 + erank] = lane; tok_w[(size_t)tk * 8 + erank] = sc / wsum * 2.5f; ents[(grp + tl) * 8 + erank] = lane; }
                }
            }
                    }
            if (gcur < tpb) {
                const int grp = gcur;
#pragma unroll
            for (int j = 0; j < 2; ++j) {
                const int tl = 2 * w + j;
                const int tk = t0 + grp + tl;
                if (grp + tl < tpb) {
                    const float* ml = modl + (tok_mb(tk) != mb0 ? 2048 : 0);
                    float ss = 0.f;
#pragma unroll
                    for (int i = 0; i < 4; ++i) ss += xv[j][i][0] * xv[j][i][0] + xv[j][i][1] * xv[j][i][1] + xv[j][i][2] * xv[j][i][2] + xv[j][i][3] * xv[j][i][3];
                    ss = wave_sum(ss);
                    const float rinv = rsqrtf(ss * (1.f / 1024.f) + EPS);
#pragma unroll
                    for (int i = 0; i < 4; ++i) {
                        const int c = lane * 4 + i * 256;
                        const float4 gs = *(const float4*)(ml + c);
                        const float4 sh = *(const float4*)(ml + 1024 + c);
                        float4 hv;
                        hv.x = xv[j][i][0] * rinv * gs.x + sh.x; hv.y = xv[j][i][1] * rinv * gs.y + sh.y;
                        hv.z = xv[j][i][2] * rinv * gs.z + sh.z; hv.w = xv[j][i][3] * rinv * gs.w + sh.w;
                        *(float4*)(hl + tl * HLS + c) = hv;
                        uint2 o; o.x = pack2(hv.x, hv.y); o.y = pack2(hv.z, hv.w);
                        *(uint2*)(hb + (size_t)tk * D + c) = o;
                        __builtin_amdgcn_sched_barrier(0);
                    }
                } else {
#pragma unroll
                    for (int i = 0; i < 4; ++i) *(float4*)(hl + tl * HLS + lane * 4 + i * 256) = make_float4(0.f, 0.f, 0.f, 0.f);
                }
            }
#pragma unroll
            for (int j = 0; j < 2; ++j) {
                const int tn = grp + 16 + 2 * w + j;
                const float* xr = xrow_cur(P, t0 + (tn < tpb ? tn : 0));
#pragma unroll
                for (int i = 0; i < 4; ++i) xv[j][i] = *(const f32x4*)(xr + lane * 4 + i * 256);
            }
            }
        }
        __syncthreads();
        {
            int* lpos = (int*)(wsb + OFF_LPOS) + (size_t)blk * tpb * 8;
            int run[8];
#pragma unroll
            for (int ee = 0; ee < 8; ++ee) run[ee] = 0;
            const int nent = tpb * 8;
            const unsigned long long ltmask = (1ull << lane) - 1ull;
            for (int c0 = 0; c0 < nent; c0 += 64) {
                const int idx = c0 + lane;
                const int ej = idx < nent ? ents[idx] : -1;
#pragma unroll
                for (int ee = 0; ee < 8; ++ee) {
                    const int e = w * 8 + ee;
                    const unsigned long long m = __ballot(ej == e);
                    if (ej == e) lpos[idx] = run[ee] + __popcll(m & ltmask);
                    run[ee] += __popcll(m);
                }
            }
            if (lane == 0) {
#pragma unroll
                for (int ee = 0; ee < 8; ++ee) ((int*)(wsb + OFF_CNT))[blk * NEXP + w * 8 + ee] = run[ee];
            }
        }
    }
}

DEV void phase_assign(const Params& P, int l, int bid, int nb, char* lds) {
    char* const wsb = opaque_ptr(P.ws);
    const int tidx = opaque_tid();
    const int ntok = (l == 1) ? TL : TT;
    const int tpb = ntok / NBLK;
    int* s_base = (int*)lds;
    int* s_tot = s_base + 64;
    int* s_n0 = s_tot + 64;
    int* s_off = s_n0 + 64;
    int* s_ub = s_off + 65;
    const int* tok_e = (const int*)(wsb + OFF_TOKE);
    const float* tok_w = (const float*)(wsb + OFF_TOKW);
    const int* lpos = (const int*)(wsb + OFF_LPOS);
    const int* cnt = (const int*)(wsb + OFF_CNT);
    int* rowslot = (int*)(wsb + OFF_ROWSLOT);
    float* rowgate = (float*)(wsb + OFF_ROWGATE);
    int* tile_e = (int*)(wsb + OFF_TILEE);
    int* ulist = (int*)(wsb + OFF_ULIST);
    for (int blk = bid; blk < NBLK; blk += nb) {
        __syncthreads();
        {
            int* s_part = s_ub + 2 * 65;
            const int e = tidx & 63, part = tidx >> 6;
            int base = 0, tot = 0, n0 = 0;
#pragma unroll 8
            for (int b2 = part * 32; b2 < part * 32 + 32; ++b2) { const int c = cnt[b2 * NEXP + e]; if (b2 < blk) base += c; if (b2 < NBLK / NPASS) n0 += c; tot += c; }
            s_part[(part * 3 + 0) * 64 + e] = base; s_part[(part * 3 + 1) * 64 + e] = tot; s_part[(part * 3 + 2) * 64 + e] = n0;
            __syncthreads();
            if (tidx < NEXP) {
                int b_ = 0, t_ = 0, n_ = 0;
#pragma unroll
                for (int p2 = 0; p2 < 8; ++p2) { b_ += s_part[(p2 * 3 + 0) * 64 + tidx]; t_ += s_part[(p2 * 3 + 1) * 64 + tidx]; n_ += s_part[(p2 * 3 + 2) * 64 + tidx]; }
                s_base[tidx] = b_; s_tot[tidx] = t_; s_n0[tidx] = n_;
            }
        }
        __syncthreads();
        if (tidx == 0) { int run = 0; for (int e = 0; e < NEXP; ++e) { s_off[e] = run; run += (s_tot[e] + 255) & ~255; } s_off[NEXP] = run; }
        __syncthreads();
        for (int i = tidx; i < tpb * 8; i += NTHREADS) {
            const size_t gi = (size_t)blk * tpb * 8 + i;
            const int e = tok_e[gi];
            const int pos = s_off[e] + s_base[e] + lpos[gi];
            const int tk = blk * tpb + (i >> 3);
            rowslot[pos] = tk * 9 + (i & 7);
            rowgate[pos] = tok_w[gi];
        }
        if (blk < NEXP) {
            const int e = blk;
            const int p0 = s_off[e] + s_tot[e], p1 = s_off[e + 1];
            for (int p = p0 + tidx; p < p1; p += NTHREADS) { rowslot[p] = -1; rowgate[p] = 0.f; }
        }
        if (blk == 0) {
            if (tidx < NEXP) { const int e = tidx; for (int tl = s_off[e] >> 8; tl < (s_off[e + 1] >> 8); ++tl) tile_e[tl] = e; }
            if (tidx == 0) tile_e[1279] = s_off[NEXP] >> 8;
            __syncthreads();
            if (tidx < 2) {
                const int h = tidx; int run = 0;
                for (int e = 0; e < NEXP; ++e) {
                    const int lo = s_off[e] + (h ? s_n0[e] : 0), hi = s_off[e] + (h ? s_tot[e] : s_n0[e]);
                    s_ub[h * 65 + e] = run;
                    if (hi > lo) run += ((hi - 1) >> 8) - (lo >> 8) + 1;
                }
                s_ub[h * 65 + NEXP] = run;
                ulist[h * 1536 + 1535] = run;
            }
            __syncthreads();
            if (tidx < 128) {
                const int h = tidx >> 6, e = tidx & 63;
                const int lo = s_off[e] + (h ? s_n0[e] : 0), hi = s_off[e] + (h ? s_tot[e] : s_n0[e]);
                if (hi > lo) { int o = s_ub[h * 65 + e]; for (int uu = lo >> 8; uu <= ((hi - 1) >> 8); ++uu) ulist[h * 1536 + o++] = uu; }
            }
        }
    }
}

DEV void phase_gemm1(const Params& P, int l, int bid, int nb, char* lds) {
    char* const wsb = opaque_ptr(P.ws);
    const int ntok = (l == 1) ? TL : TT;
    const int* tile_e = (const int*)(wsb + OFF_TILEE);
    const int nrt = tile_e[1279];
    const int nst = ntok / 256;
    const int* rowslot = (const int*)(wsb + OFF_ROWSLOT);
    const u16* A = (const u16*)(wsb + OFF_HBUF);
    const int nun = (nrt + nst) * 2, per8 = (nun + 7) >> 3;
    const int ubase = (bid & 7) * per8, ustep = nb >> 3;
    const float* rowgate = (const float*)(wsb + OFF_ROWGATE);
    auto setup = [&](int i, GemmPre& g, u16*& dst, const float*& gp) {
        const int mt = i >> 1, nt_ = i & 1;
        gp = (mt < nrt) ? rowgate + mt * 256 : nullptr;
        if (mt < nrt) {
            const int e = tile_e[mt];
            const int* rs = rowslot + mt * 256;
            gemm_pre_make(g, A, [=](int r) -> u32 { const int sl = rs[r]; return (u32)(sl < 0 ? 0 : sl / 9) * D; }, (const u16*)(wsb + OFF_W1) + ((size_t)e * 512 + nt_ * 256) * D, D);
            dst = (u16*)(wsb + OFF_ACT) + (size_t)mt * 256 * 256 + nt_ * 128;
        } else {
            const int row0 = (mt - nrt) * 256;
            gemm_pre_make(g, A, [=](int r) -> u32 { return (u32)(row0 + r) * D; }, (const u16*)(wsb + OFF_WSH1) + ((size_t)l * 512 + nt_ * 256) * D, D);
            dst = (u16*)(wsb + OFF_ACTSH) + (size_t)row0 * 256 + nt_ * 128;
        }
    };
    int uu = bid >> 3;
    GemmPre cur; u16* cdst = nullptr; const float* cgp = nullptr;
    bool have = (uu < per8) && (ubase + uu < nun);
    if (have) { setup(ubase + uu, cur, cdst, cgp); __syncthreads(); gemm_pre_issue(cur, lds); }
    while (have) {
        const int un = uu + ustep;
        const bool have_n = (un < per8) && (ubase + un < nun);
        GemmPre nxt; u16* ndst = nullptr; const float* ngp = nullptr;
        if (have_n) setup(ubase + un, nxt, ndst, ngp);
        u16* const dst = cdst; const float* const gp = cgp;
        gemm_tile_pipe(cur, lds,
            [&]() { if (have_n) gemm_pre_issue(nxt, lds); },
            [&](f32x4 (&acc)[2][2][4][2], int wr, int wc, int fr, int fq) {
#pragma unroll
                for (int ai = 0; ai < 2; ++ai)
#pragma unroll
                    for (int m = 0; m < 4; ++m) {
                        const float gsc = gp ? gp[ai * HALF + wr * 64 + m * 16 + fr] * 32.f : 1.f;
#pragma unroll
                        for (int n = 0; n < 2; ++n) {
                            float o[4];
#pragma unroll
                            for (int jj = 0; jj < 4; ++jj) o[jj] = silu_f(acc[ai][0][m][n][jj]) * acc[ai][1][m][n][jj] * gsc;
                            uint2 pk; pk.x = cvt_pk_bf16(o[0], o[1]); pk.y = cvt_pk_bf16(o[2], o[3]);
                            *(uint2*)(dst + (size_t)(ai * HALF + wr * 64 + m * 16 + fr) * 256 + wc * 32 + n * 16 + fq * 4) = pk;
                        }
                    }
            });
        cur = nxt; cdst = ndst; cgp = ngp; uu = un; have = have_n;
    }
}

DEV void phase_gemm2(const Params& P, int l, int hx, int bid, int nb, char* lds) {
    char* const wsb = opaque_ptr(P.ws);
    const int ntok = (l == 1) ? TL : TT;
    const int nhalf = ntok / NPASS;
    const int* tile_e = (const int*)(wsb + OFF_TILEE);
    const int* ulist = (const int*)(wsb + OFF_ULIST) + hx * 1536;
    const int n_ru = ulist[1535];
    const int nst = nhalf / 256;
    const int* rowslot = (const int*)(wsb + OFF_ROWSLOT);
    unsigned char* yk = (unsigned char*)(wsb + OFF_YK);
#define G2_WAIT(n) asm volatile("s_waitcnt vmcnt(" #n ")" ::: "memory")
    const int nun = n_ru + nst, per8 = (nun + 7) >> 3;
    const int ustep = nb >> 3, u0 = (bid & 7) * per8 + (bid >> 3);
    int nk = 0;
    {
        int lim = nun - (bid & 7) * per8; if (lim > per8) lim = per8;
        const int first = bid >> 3;
        if (first < lim) nk = (lim - first + ustep - 1) / ustep;
    }
    if (nk == 0) return;
    const int total = nk * 16;
    const int tidx = opaque_tid();
    const int w = tidx >> 6, lane = tidx & 63, fr = lane & 15, fq = lane >> 4, wr = w >> 1, wc = w & 1;
    const int prow = tidx >> 5, pch = tidx & 31;
    const u16* const W2b = (const u16*)(wsb + OFF_W2);
    const u16* const WSb = (const u16*)(wsb + OFF_WSH2) + (size_t)l * D * 256;
    int* const s_u = (int*)(lds + 4 * 32768);
    __syncthreads();
    if (tidx < 16 && tidx < nk) {
        const int u = u0 + tidx * ustep;
        if (u < n_ru) { const int t = ulist[u]; s_u[2 * tidx] = t; s_u[2 * tidx + 1] = tile_e[t]; }
        else { s_u[2 * tidx] = -1 - (u - n_ru); s_u[2 * tidx + 1] = 64; }
    }
    __syncthreads();
#define G2_UNIT_E(k) __builtin_amdgcn_readfirstlane(s_u[2 * (k) + 1])
#define G2_UNIT_BT(k) (G2_UNIT_E(k) < 64 ? W2b + (size_t)G2_UNIT_E(k) * D * 256 : WSb)
    const u16* BtL = G2_UNIT_BT(0);
#define G2_ISSUE(gi) do { const int _c = (gi) & 15; \
        const u16* _s0 = BtL + (size_t)((_c >> 1) * 128 + (prow >> 2) * 16 + (_c & 1) * 8 + (prow & 3)) * 256 + ((pch ^ prow) * 8); \
        _Pragma("unroll") for (int ps = 0; ps < 4; ++ps) \
            __builtin_amdgcn_global_load_lds((const unsigned*)(_s0 + (size_t)((ps >> 1) * 64 + (ps & 1) * 4) * 256), \
                (LAS unsigned*)((LAS char*)lds + ((gi) & 3) * 32768 + ps * 8192 + tidx * 16), 16, 0, 0); } while (0)
    G2_ISSUE(0); G2_ISSUE(1); G2_ISSUE(2);
    bf16x8 af[4][8];
    u32 yo[4];
    bool routed = true;
#define G2_UNIT_SETUP(k) do { \
        const int ut = __builtin_amdgcn_readfirstlane(s_u[2 * (k)]); \
        routed = ut >= 0; \
        const int su = -1 - ut;                         \
        const u16* A; int urow; \
        if (routed) { urow = ut * 256; A = (const u16*)(wsb + OFF_ACT) + (size_t)urow * 256; } \
        else { urow = hx * nhalf + su * 256; A = (const u16*)(wsb + OFF_ACTSH) + (size_t)urow * 256; } \
        const u16* ap = A + (size_t)(wr * 64 + fr) * 256 + fq * 8; \
        _Pragma("unroll") for (int m = 0; m < 4; ++m) _Pragma("unroll") for (int ks = 0; ks < 8; ++ks) \
            af[m][ks] = *reinterpret_cast<const bf16x8*>(ap + m * 16 * 256 + ks * 32); \
        _Pragma("unroll") for (int m = 0; m < 4; ++m) { \
            const int R = wr * 64 + m * 16 + fr; int slot; \
            if (routed) { const int sl = rowslot[urow + R]; const int ls = sl - hx * nhalf * 9; \
                slot = (sl < 0 || ls < 0 || ls >= nhalf * 9) ? nhalf * 9 : ls; }     \
            else slot = (su * 256 + R) * 9 + 8; \
              \
            const int tl9 = slot / 9, k9 = slot - tl9 * 9; \
            yo[m] = (u32)tl9 * 10240u + (u32)k9 * 1024u + (u32)(routed ? (wc * 64 + fq * 16) : (wc * 64 + fq * 16) * 2); } \
          \
        asm volatile("" :: "v"(af[0][0]), "v"(af[0][1]), "v"(af[0][2]), "v"(af[0][3]), "v"(af[0][4]), "v"(af[0][5]), "v"(af[0][6]), "v"(af[0][7]), \
                           "v"(af[1][0]), "v"(af[1][1]), "v"(af[1][2]), "v"(af[1][3]), "v"(af[1][4]), "v"(af[1][5]), "v"(af[1][6]), "v"(af[1][7])); \
        asm volatile("" :: "v"(af[2][0]), "v"(af[2][1]), "v"(af[2][2]), "v"(af[2][3]), "v"(af[2][4]), "v"(af[2][5]), "v"(af[2][6]), "v"(af[2][7]), \
                           "v"(af[3][0]), "v"(af[3][1]), "v"(af[3][2]), "v"(af[3][3]), "v"(af[3][4]), "v"(af[3][5]), "v"(af[3][6]), "v"(af[3][7])); } while (0)
#define G2_BREAD(dst, gi, n, kh) do { const char* _bb = lds + ((gi) & 3) * 32768 + (wc * 32 + (n) * 16 + fr) * 512; \
        _Pragma("unroll") for (int k4 = 0; k4 < 4; ++k4) dst[k4] = *reinterpret_cast<const bf16x8*>(_bb + (((((kh) * 4 + k4) * 4 + fq) ^ fr) * 16)); } while (0)
#define G2_MMA(accv, bv, kh) do { _Pragma("unroll") for (int k4 = 0; k4 < 4; ++k4) _Pragma("unroll") for (int m = 0; m < 4; ++m) \
        accv[m] = __builtin_amdgcn_mfma_f32_16x16x32_bf16(bv[k4], af[m][(kh) * 4 + k4], accv[m], 0, 0, 0); } while (0)
    G2_UNIT_SETUP(0);
    G2_WAIT(0);
    __builtin_amdgcn_s_barrier();
    G2_ISSUE(3);
    bf16x8 bX[4], bY[4];
    G2_BREAD(bX, 0, 0, 0);
#define G2_PK8(dst, accv) do { \
        const float v0 = __builtin_amdgcn_fmed3f(accv[0], -440.f, 440.f), v1 = __builtin_amdgcn_fmed3f(accv[1], -440.f, 440.f); \
        const float v2 = __builtin_amdgcn_fmed3f(accv[2], -440.f, 440.f), v3 = __builtin_amdgcn_fmed3f(accv[3], -440.f, 440.f); \
        int pk = __builtin_amdgcn_cvt_pk_fp8_f32(v0, v1, 0, false); \
        pk = __builtin_amdgcn_cvt_pk_fp8_f32(v2, v3, pk, true); dst = (u32)pk; } while (0)
#pragma unroll 1
    for (int gp = 0; gp < total / 2; ++gp) {
        const int p = gp & 7;
        u32 pkq[4][4];
#pragma unroll
        for (int ci = 0; ci < 2; ++ci) {
            const int g = gp * 2 + ci;
            u32 sh[4][2];
            {
                f32x4 acc0[4] = {};
                __builtin_amdgcn_s_waitcnt(0xC07F);
                G2_BREAD(bY, g, 0, 1);
                __builtin_amdgcn_sched_barrier(0);
                G2_MMA(acc0, bX, 0);
                __builtin_amdgcn_sched_barrier(0);
                G2_BREAD(bX, g, 1, 0);
                __builtin_amdgcn_s_waitcnt(0xC47F);
                asm volatile("s_nop 0");
                __builtin_amdgcn_sched_barrier(0);
                G2_MMA(acc0, bY, 1);
                __builtin_amdgcn_sched_barrier(0);
                if (routed) {
#pragma unroll
                    for (int m = 0; m < 4; ++m) G2_PK8(pkq[m][ci * 2], acc0[m]);
                } else {
#pragma unroll
                    for (int m = 0; m < 4; ++m) { sh[m][0] = cvt_pk_bf16(acc0[m][0], acc0[m][1]); sh[m][1] = cvt_pk_bf16(acc0[m][2], acc0[m][3]); }
                }
                __builtin_amdgcn_sched_barrier(0);
            }
            f32x4 acc1[4] = {};
            __builtin_amdgcn_s_waitcnt(0xC07F);
            G2_BREAD(bY, g, 1, 1);
            __builtin_amdgcn_sched_barrier(0);
            G2_MMA(acc1, bX, 0);
            __builtin_amdgcn_sched_barrier(0);
            __builtin_amdgcn_s_waitcnt(0xC07F);
            asm volatile("s_nop 0");
            if (g + 1 < total) {
                if (g + 3 >= total) G2_WAIT(0);
                else if (ci == 0 && g >= 4) G2_WAIT(16);
                else G2_WAIT(12);
                asm volatile("s_waitcnt lgkmcnt(0)" ::: "memory");
                __builtin_amdgcn_s_barrier();
                if (g + 4 < total) {
                    if (((g + 4) & 15) == 0) BtL = G2_UNIT_BT((g + 4) >> 4);
                    G2_ISSUE(g + 4);
                }
                G2_BREAD(bX, g + 1, 0, 0);
                __builtin_amdgcn_sched_barrier(0);
            }
            G2_MMA(acc1, bY, 1);
            __builtin_amdgcn_sched_barrier(0);
            if (!routed) {
#pragma unroll
                for (int m = 0; m < 4; ++m) {
                    u32x4 s0 = {sh[m][0], sh[m][1], cvt_pk_bf16(acc1[m][0], acc1[m][1]), cvt_pk_bf16(acc1[m][2], acc1[m][3])};
                    *(u32x4*)(yk + yo[m] + p * 256 + ci * 16) = s0;
                }
            } else {
#pragma unroll
                for (int m = 0; m < 4; ++m) G2_PK8(pkq[m][ci * 2 + 1], acc1[m]);
            }
        }
        if (routed) {
#pragma unroll
            for (int m = 0; m < 4; ++m) {
                u32x4 s0 = {pkq[m][0], pkq[m][1], pkq[m][2], pkq[m][3]};
                *(u32x4*)(yk + yo[m] + p * 128) = s0;
            }
        }
        if (p == 7 && gp + 1 < total / 2) G2_UNIT_SETUP((gp + 1) >> 3);
    }
#undef G2_UNIT_SETUP
#undef G2_PK8
#undef G2_BREAD
#undef G2_MMA
    asm volatile("s_waitcnt lgkmcnt(0)" ::: "memory");
    __builtin_amdgcn_s_barrier();
#undef G2_ISSUE
#undef G2_UNIT_BT
#undef G2_UNIT_E
#undef G2_WAIT
}

DEV void phase_combine(const Params& P, int l, int hx, int bid, int nb) {
    char* const wsb = opaque_ptr(P.ws);
    const int tidx = opaque_tid();
    const int ntok = (l == 1) ? TL : TT;
    const int nhalf = ntok / NPASS;
    const float* mod = (const float*)(wsb + OFF_MOD) + (size_t)l * 9 * 6144;
    const u16* yk = (const u16*)(wsb + OFF_YK);
    const int sub = tidx & 127;
    for (int tl = bid * 4 + (tidx >> 7); tl < nhalf; tl += nb * 4) {
        const int tk = hx * nhalf + tl;
        float acc[8];
#pragma unroll
        for (int j = 0; j < 8; ++j) acc[j] = 0.f;
#if YK_FP8
        typedef float f2v __attribute__((ext_vector_type(2)));
#pragma unroll
        for (int k = 0; k < 8; ++k) {
            const uint2 q = *(const uint2*)((const unsigned char*)yk + (size_t)tl * 10240 + k * 1024 + sub * 8);
            const f2v a0 = __builtin_amdgcn_cvt_pk_f32_fp8((int)q.x, false), a1 = __builtin_amdgcn_cvt_pk_f32_fp8((int)q.x, true);
            const f2v a2 = __builtin_amdgcn_cvt_pk_f32_fp8((int)q.y, false), a3 = __builtin_amdgcn_cvt_pk_f32_fp8((int)q.y, true);
            acc[0] += a0[0]; acc[1] += a0[1]; acc[2] += a1[0]; acc[3] += a1[1];
            acc[4] += a2[0]; acc[5] += a2[1]; acc[6] += a3[0]; acc[7] += a3[1];
        }
        {
            float ys[8]; unpack8(*(const uint4*)((const unsigned char*)yk + (size_t)tl * 10240 + 8192 + sub * 16), ys);
#pragma unroll
            for (int j = 0; j < 8; ++j) acc[j] = acc[j] * (1.f / 32.f) + ys[j];
        }
#else
#pragma unroll
        for (int k = 0; k < 9; ++k) {
            float y[8]; unpack8(*(const uint4*)(yk + ((size_t)tl * 9 + k) * D + sub * 8), y);
#pragma unroll
            for (int j = 0; j < 8; ++j) acc[j] += y[j];
        }
#endif
        float* xr = xrow_cur(P, tk) + sub * 8;
        const float* gt = mod + (size_t)tok_mb(tk) * 6144 + 5120 + sub * 8;
        float4 x0 = *(const float4*)xr, x1 = *(const float4*)(xr + 4);
        const float4 g0 = *(const float4*)gt, g1 = *(const float4*)(gt + 4);
        x0.x += g0.x * acc[0]; x0.y += g0.y * acc[1]; x0.z += g0.z * acc[2]; x0.w += g0.w * acc[3];
        x1.x += g1.x * acc[4]; x1.y += g1.y * acc[5]; x1.z += g1.z * acc[6]; x1.w += g1.w * acc[7];
        *(float4*)xr = x0; *(float4*)(xr + 4) = x1;
    }
}

typedef __attribute__((address_space(4))) const char k4char;
DEV const Params& kparams() {
    k4char* p = (k4char*)__builtin_amdgcn_kernarg_segment_ptr();
    asm volatile("" : "+s"(p));
    return *(const Params*)p;
}
enum { PH_INIT = 0, PH_PREP, PH_INPROJ, PH_ATTNA, PH_ATTNN, PH_S5SCAN, PH_S5READ, PH_OUTPROJ, PH_NORM2, PH_COUNT, PH_ASSIGN, PH_GEMM1, PH_GEMM2, PH_COMBINE, PH_POISON };

template <int PH>
__global__ void __launch_bounds__(NTHREADS, 2) k_phase(Params P) {
    extern __shared__ __attribute__((aligned(16))) char lds[];
    const int bid = blockIdx.x, nb = gridDim.x, l = P.layer, q = P.sub;
    (void)l; (void)q; (void)lds;
#if !ONE_LAUNCH
    if (PH == PH_INIT) phase_init(P, bid, nb, lds);
    if (PH == PH_PREP) phase_prep(P, l, bid, nb, lds);
    if (PH == PH_INPROJ) phase_inproj(P, l, bid, nb, lds);
#if NAIVE_ATTN
    if (PH == PH_ATTNA) phase_attnA_naive(P, l, bid, nb);
    if (PH == PH_ATTNN) phase_attnN_naive(P, l, bid, nb);
#else
    if (PH == PH_ATTNA) phase_attnA(P, l, bid, nb, lds);
    if (PH == PH_ATTNN) phase_attnN(P, l, bid, nb, lds);
#endif
#if NAIVE_S5
    if (PH == PH_S5SCAN) phase_s5_scan_naive(P, l, bid, nb);
    if (PH == PH_S5READ) phase_s5_readout_naive(P, l, bid, nb, lds);
#endif
    if (PH == PH_OUTPROJ) phase_outproj(P, l, bid, nb, lds);
    if (PH == PH_NORM2) phase_norm2_router(P, l, bid, nb, lds);
    if (PH == PH_ASSIGN) phase_assign(P, l, bid, nb, lds);
    if (PH == PH_GEMM1) phase_gemm1(P, l, bid, nb, lds);
    if (PH == PH_GEMM2) phase_gemm2(P, l, q, bid, nb, lds);
    if (PH == PH_COMBINE) phase_combine(P, l, q, bid, nb);
#endif
    if (PH == PH_POISON) { for (size_t i = (size_t)bid * NTHREADS + threadIdx.x; i < (size_t)TL * D; i += (size_t)nb * NTHREADS) P.out[i] = __uint_as_float(0x7FC00000u); }
}


#if ONE_LAUNCH
__global__ void __launch_bounds__(NTHREADS, 2) k_mega(Params Pin) {
    extern __shared__ __attribute__((aligned(16))) char lds[];
    if (threadIdx.x == 0) *(uint4*)(lds + LDS_BYTES - 16) = make_uint4(0u, 0u, 0u, 0u);
    if ((threadIdx.x & 63) == 0) ((volatile LAS unsigned char*)(LAS char*)lds)[LDS_TID_TABLE + hw_wave_slot()] = (unsigned char)(threadIdx.x >> 6);
    __syncthreads();
    XcdBarrier bar = xcd_barrier_post((unsigned*)(kparams().ws + OFF_BAR), (volatile LAS unsigned*)(LAS char*)(lds + LDS_BYTES - 16));
    phase_init(kparams(), opaque_s((int)blockIdx.x), opaque_s((int)gridDim.x), lds);
    s5_kf_init(kparams(), opaque_s((int)blockIdx.x), opaque_s((int)gridDim.x), lds);
    xcd_barrier(bar);
#define RUN(id, stmt) do { stmt; if (REPEAT_PH == (id)) { xcd_barrier(bar); stmt; } } while (0)
    for (int l = 0; l < 2; ++l) {
        RUN(1, { phase_prep(kparams(), l, opaque_s((int)blockIdx.x), opaque_s((int)gridDim.x), lds); s5_gen(kparams(), l, opaque_s((int)blockIdx.x), opaque_s((int)gridDim.x), lds); });
        xcd_barrier(bar);
        RUN(2, phase_inproj(kparams(), l, opaque_s((int)blockIdx.x), opaque_s((int)gridDim.x), lds));
        xcd_barrier(bar);
        RUN(3, { phase_s5_E(kparams(), l, opaque_s((int)blockIdx.x), opaque_s((int)gridDim.x), lds); phase_attnN(kparams(), l, opaque_s((int)blockIdx.x), opaque_s((int)gridDim.x), lds); });
        xcd_barrier(bar);
        RUN(4, phase_s5_carry(kparams(), l, opaque_s((int)blockIdx.x), opaque_s((int)gridDim.x)));
        xcd_barrier(bar);
        RUN(5, phase_s5_Y(kparams(), l, opaque_s((int)blockIdx.x), opaque_s((int)gridDim.x), lds));
        xcd_barrier(bar);
        RUN(6, { phase_s5_glu(kparams(), l, opaque_s((int)blockIdx.x), opaque_s((int)gridDim.x), lds); phase_attnA(kparams(), l, opaque_s((int)blockIdx.x), opaque_s((int)gridDim.x), lds); });
        xcd_barrier(bar);
        phase_outproj(kparams(), l, opaque_s((int)blockIdx.x), opaque_s((int)gridDim.x), lds);
        xcd_barrier(bar);
        RUN(8, phase_norm2_router(kparams(), l, opaque_s((int)blockIdx.x), opaque_s((int)gridDim.x), lds));
        xcd_barrier(bar);
        RUN(10, phase_assign(kparams(), l, opaque_s((int)blockIdx.x), opaque_s((int)gridDim.x), lds));
        xcd_barrier(bar);
        RUN(11, phase_gemm1(kparams(), l, opaque_s((int)blockIdx.x), opaque_s((int)gridDim.x), lds));
        xcd_barrier(bar);
        for (int hx = 0; hx < NPASS; ++hx) {
            RUN(12, phase_gemm2(kparams(), l, hx, opaque_s((int)blockIdx.x), opaque_s((int)gridDim.x), lds));
            xcd_barrier(bar);
            phase_combine(kparams(), l, hx, opaque_s((int)blockIdx.x), opaque_s((int)gridDim.x));
            xcd_barrier(bar);
        }
    }
}
#endif

template <int PH>
static void launch_phase(Params& P, int l, int q, hipStream_t stream) {
    static bool attr_done = false;
    if (!attr_done) { (void)hipFuncSetAttribute((const void*)k_phase<PH>, hipFuncAttributeMaxDynamicSharedMemorySize, LDS_BYTES); attr_done = true; }
    P.layer = l; P.sub = q;
    hipLaunchKernelGGL(k_phase<PH>, dim3(NBLK), dim3(NTHREADS), LDS_BYTES, stream, P);
}

extern "C" void kernel_launch(void* const* d_in, const int* in_sizes, int n_in, void* d_out, int out_size, void* d_ws, size_t ws_size, hipStream_t stream) {
    Params P;
    memset(&P, 0, sizeof(P));
    for (int i = 0; i < 35; ++i) P.in[i] = (const float*)d_in[i];
    P.out = (float*)d_out; P.ws = (char*)d_ws;
    if (n_in != 35 || ws_size < WS_NEED) {
        fprintf(stderr, "kernel_launch: need %zu bytes of workspace, got %zu (n_in %d)\n", (size_t)WS_NEED, ws_size, n_in);
        launch_phase<PH_POISON>(P, 0, 0, stream);
        return;
    }
    (void)hipMemsetAsync(d_ws, 0, 16384, stream);
#if ONE_LAUNCH
    {
        static bool attr_done = false;
        if (!attr_done) { (void)hipFuncSetAttribute((const void*)k_mega, hipFuncAttributeMaxDynamicSharedMemorySize, LDS_BYTES); attr_done = true; }
        hipLaunchKernelGGL(k_mega, dim3(NBLK), dim3(NTHREADS), LDS_BYTES, stream, P);
        return;
    }
#endif
#if !ONE_LAUNCH
    launch_phase<PH_INIT>(P, 0, 0, stream);
    for (int l = 0; l < 2; ++l) {
        launch_phase<PH_PREP>(P, l, 0, stream);
        launch_phase<PH_INPROJ>(P, l, 0, stream);
        launch_phase<PH_ATTNA>(P, l, 0, stream);
        launch_phase<PH_ATTNN>(P, l, 0, stream);
        launch_phase<PH_S5SCAN>(P, l, 0, stream);
        launch_phase<PH_S5READ>(P, l, 0, stream);
        launch_phase<PH_OUTPROJ>(P, l, 0, stream);
        launch_phase<PH_NORM2>(P, l, 0, stream);
        launch_phase<PH_COUNT>(P, l, 0, stream);
        launch_phase<PH_ASSIGN>(P, l, 0, stream);
        launch_phase<PH_GEMM1>(P, l, 0, stream);
        for (int q = 0; q < 4; ++q) {
            launch_phase<PH_GEMM2>(P, l, q, stream);
            launch_phase<PH_COMBINE>(P, l, q, stream);
        }
    }
#endif
}
```

```cpp
#include <hip/hip_runtime.h>
#include <stdint.h>
#include <stdio.h>
#include <string.h>

#ifndef ONE_LAUNCH
#define ONE_LAUNCH 1
#endif
#ifndef REPEAT_PH
#define REPEAT_PH 0
#endif
#ifndef YK_FP8
#define YK_FP8 1
#endif
#ifndef NAIVE_GEMM
#define NAIVE_GEMM 0
#endif
#ifndef NAIVE_ATTN
#define NAIVE_ATTN 0
#endif
#ifndef NAIVE_S5
#define NAIVE_S5 0
#endif

#define DEV __device__ __forceinline__
typedef unsigned short u16;
typedef unsigned int u32;
using bf16x8 = __attribute__((ext_vector_type(8))) short;
using f32x4 = __attribute__((ext_vector_type(4))) float;
using f32x16 = __attribute__((ext_vector_type(16))) float;
using u32x4 = __attribute__((ext_vector_type(4))) unsigned;
#define LAS __attribute__((address_space(3)))

constexpr int D = 1024, NBATCH = 8, SEQ = 4096, LCTX = 256;
constexpr int TL = NBATCH * SEQ;
constexpr int TC = NBATCH * LCTX;
constexpr int TT = TL + TC;
constexpr int INC = 2560;
constexpr int NKEY = SEQ + LCTX;
constexpr int NEXP = 64;
constexpr int NTHREADS = 512;
constexpr int NBLK = 256;
constexpr int MAXROWS = TT * 8 + NEXP * 256;
constexpr int NPASS = 1;
constexpr int THALF = TT / NPASS;
constexpr float EPS = 1e-6f;
constexpr float LOG2E = 1.4426950408889634f;

constexpr size_t al(size_t x) { return (x + 255) & ~(size_t)255; }
constexpr size_t OFF_BAR = 0;
constexpr size_t OFF_MOD = OFF_BAR + 16384;
constexpr size_t OFF_ROPE = OFF_MOD + al(2 * 9 * 6144 * 4);
constexpr size_t OFF_MISC = OFF_ROPE + al(2 * 64 * 8 * 4);
constexpr size_t OFF_CNT = OFF_MISC + 4096;
constexpr size_t OFF_TILEE = OFF_CNT + al(256 * 64 * 4);
constexpr size_t OFF_ULIST = OFF_TILEE + al(1280 * 4);
constexpr size_t OFF_TOKE = OFF_ULIST + al(2 * 1536 * 4);
constexpr size_t OFF_TOKW = OFF_TOKE + al((size_t)TT * 8 * 4);
constexpr size_t OFF_LPOS = OFF_TOKW + al((size_t)TT * 8 * 4);
constexpr size_t OFF_ROWSLOT = OFF_LPOS + al((size_t)TT * 8 * 4);
constexpr size_t OFF_ROWGATE = OFF_ROWSLOT + al((size_t)MAXROWS * 4);
constexpr size_t OFF_KF = OFF_ROWGATE + al((size_t)MAXROWS * 4);
constexpr size_t OFF_WIN = OFF_KF + al((size_t)2 * 16 * 2 * 32 * 256 * 4);
constexpr size_t OFF_WOUT = OFF_WIN + al((size_t)2 * INC * D * 2);
constexpr size_t OFF_WGLU = OFF_WOUT + al((size_t)2 * D * D * 2);
constexpr size_t OFF_WSH1 = OFF_WGLU + al((size_t)2 * 256 * 256 * 2);
constexpr size_t OFF_WSH2 = OFF_WSH1 + al((size_t)2 * 512 * D * 2);
constexpr size_t OFF_CTXS = OFF_WSH2 + al((size_t)2 * D * 256 * 2);
constexpr size_t OFF_W2 = OFF_CTXS + al((size_t)TC * D * 4);
constexpr size_t OFF_W1 = OFF_W2 + al((size_t)NEXP * D * 256 * 2);
constexpr size_t OFF_HBUF = OFF_W1 + al((size_t)NEXP * 512 * D * 2);
constexpr size_t OFF_M1 = OFF_HBUF + al((size_t)TT * D * 2);
constexpr size_t OFF_M3 = OFF_M1 + al((size_t)16 * 256 * 512 * 2);
constexpr size_t OFF_R = OFF_M3 + al((size_t)16 * 512 * 768 * 2);
constexpr size_t OFF_QA = OFF_R;
constexpr size_t OFF_QAC = OFF_QA + al((size_t)NBATCH * 6 * 2 * SEQ * 32 * 2);
constexpr size_t OFF_KA = OFF_QAC + al((size_t)NBATCH * 6 * 2 * LCTX * 32 * 2);
constexpr size_t OFF_VAT = OFF_KA + al((size_t)NBATCH * 6 * NKEY * 64 * 2);
constexpr size_t OFF_QN = OFF_VAT + al((size_t)NBATCH * 6 * NKEY * 64 * 2);
constexpr size_t OFF_QNC = OFF_QN + al((size_t)NBATCH * 6 * SEQ * 64 * 2);
constexpr size_t OFF_KN = OFF_QNC + al((size_t)NBATCH * 6 * LCTX * 64 * 2);
constexpr size_t OFF_VNT = OFF_KN + al((size_t)NBATCH * 6 * NKEY * 64 * 2);
constexpr size_t OFF_U = OFF_VNT + al((size_t)NBATCH * 6 * NKEY * 64 * 2);
constexpr size_t OFF_XS5 = OFF_U + al((size_t)TT * 256 * 2);
constexpr size_t OFF_ES5 = OFF_XS5 + al((size_t)16 * 1088 * 768 * 2);
constexpr size_t OFF_GBUF = OFF_ES5 + al((size_t)16 * 1088 * 256 * 2);
constexpr size_t OFF_MIXEND = OFF_GBUF + al((size_t)TT * 256 * 2);
constexpr size_t OFF_YK = OFF_W1;
constexpr size_t OFF_ACT = OFF_YK + al((size_t)(THALF + 1) * 10240);
constexpr size_t OFF_ACTSH = OFF_ACT + al((size_t)MAXROWS * 256 * 2);
constexpr size_t OFF_MOEEND = OFF_ACTSH + al((size_t)TT * 256 * 2);
constexpr size_t WS_NEED = OFF_MIXEND > OFF_MOEEND ? OFF_MIXEND : OFF_MOEEND;

constexpr int LDS_BYTES = 160 * 1024;
constexpr int CS_STRIDE = 264;

struct Params {
    const float* in[35];
    float* out;
    char* ws;
    int layer;
    int sub;
};

enum { I_X = 0, I_C, I_CTX, I_CCTX, I_WMOD, I_BMOD, I_GMIX, I_GFFN, I_WIN, I_WOUT, I_AGQ, I_AGK, I_ALAM, I_AGSUB, I_NGQ, I_NGK, I_NRPB,
       I_S5ARE, I_S5AIM, I_S5LDT, I_S5BRE, I_S5BIM, I_S5CRE, I_S5CIM, I_S5D, I_S5WGLU, I_S5BGLU, I_WROUTER, I_EBIAS, I_WGATE, I_WUP, I_WDOWN,
       I_WSGATE, I_WSUP, I_WSDOWN };

struct Params;
typedef __attribute__((address_space(1))) char g1char;
DEV char* opaque_ptr(char* p) { g1char* g = (g1char*)p; asm volatile("" : "+s"(g)); return (char*)g; }
DEV int opaque_s(int x) { asm volatile("" : "+s"(x)); return x; }
extern __shared__ __attribute__((aligned(16))) char lds_dyn[];
constexpr int LDS_TID_TABLE = 160 * 1024 - 16 - 64;
DEV unsigned hw_wave_slot() { return (unsigned)__builtin_amdgcn_s_getreg((5 << 11) | 4) & 63u; }
DEV int plain_tid() {
    const int wv = __builtin_amdgcn_readfirstlane((int)((volatile LAS unsigned char*)(LAS char*)lds_dyn)[LDS_TID_TABLE + hw_wave_slot()]);
    int lane;
    asm volatile("v_mbcnt_lo_u32_b32 %0, -1, 0\n\tv_mbcnt_hi_u32_b32 %0, -1, %0" : "=v"(lane));
    return (wv << 6) | lane;
}
DEV int opaque_tid() { int t = plain_tid(); asm volatile("" : "+v"(t)); return t; }

DEV float bf2f(u16 b) { return __uint_as_float(((u32)b) << 16); }
DEV u16 f2bf(float f) { u32 u = __float_as_uint(f); u += 0x7FFFu + ((u >> 16) & 1u); return (u16)(u >> 16); }
typedef __bf16 bf16v2_t __attribute__((ext_vector_type(2)));
typedef float f32v2_t __attribute__((ext_vector_type(2)));
DEV u32 cvt_pk_bf16(float lo, float hi) { f32v2_t v = {lo, hi}; bf16v2_t b = __builtin_convertvector(v, bf16v2_t); return __builtin_bit_cast(u32, b); }
DEV u32 pack2(float lo, float hi) { return cvt_pk_bf16(lo, hi); }
template <int CTRL>
DEV float dppf(float v) { return __int_as_float(__builtin_amdgcn_update_dpp(0, __float_as_int(v), CTRL, 0xF, 0xF, true)); }
DEV float lane_bcast(float v, int l) { return __int_as_float(__builtin_amdgcn_readlane(__float_as_int(v), l)); }
DEV float wave_sum(float v) {
    v += dppf<0xB1>(v); v += dppf<0x4E>(v); v += dppf<0x141>(v); v += dppf<0x140>(v);
    return (lane_bcast(v, 0) + lane_bcast(v, 16)) + (lane_bcast(v, 32) + lane_bcast(v, 48));
}
DEV float xor32(float v) {
    const int l = opaque_tid() & 63;
    return __int_as_float(__builtin_amdgcn_ds_bpermute((l ^ 32) << 2, __float_as_int(v)));
}
DEV float max8(float v) {
    v = fmaxf(v, dppf<0xB1>(v)); v = fmaxf(v, dppf<0x4E>(v)); v = fmaxf(v, dppf<0x141>(v));
    return v;
}
DEV float fast_rcp(float x) { return __builtin_amdgcn_rcpf(x); }
DEV float silu_f(float x) { return x * fast_rcp(1.f + __expf(-x)); }
DEV float sigmoid_f(float x) { return fast_rcp(1.f + __expf(-x)); }
DEV float gelu_tanh(float x) {
    const float k = 0.7978845608028654f;
    float u = k * (x + 0.044715f * x * x * x);
    float t = 1.f - 2.f * fast_rcp(1.f + __expf(2.f * u));
    return 0.5f * x * (1.f + t);
}
DEV void unpack8(const uint4& q, float* f) {
    f[0] = __uint_as_float(q.x << 16); f[1] = __uint_as_float(q.x & 0xFFFF0000u);
    f[2] = __uint_as_float(q.y << 16); f[3] = __uint_as_float(q.y & 0xFFFF0000u);
    f[4] = __uint_as_float(q.z << 16); f[5] = __uint_as_float(q.z & 0xFFFF0000u);
    f[6] = __uint_as_float(q.w << 16); f[7] = __uint_as_float(q.w & 0xFFFF0000u);
}
DEV uint4 pack8(const float* f) {
    uint4 q; q.x = pack2(f[0], f[1]); q.y = pack2(f[2], f[3]); q.z = pack2(f[4], f[5]); q.w = pack2(f[6], f[7]); return q;
}
DEV bool tok_lat(int t) { return t < TL; }
DEV int tok_b(int t) { return t < TL ? (t >> 12) : ((t - TL) >> 8); }
DEV int tok_mb(int t) { return t < TL ? (t >> 12) : 8; }
DEV float lam_init_of(int l) { return l == 0 ? 0.2f : (0.8f - 0.6f * 0.7408182206817179f); }

DEV const float* xrow_prev(const Params& P, int l, int t) {
    char* const wsb = opaque_ptr(P.ws);
    if (t < TL) return (l == 0 ? P.in[I_X] : P.out) + (size_t)t * D;
    return (l == 0 ? P.in[I_CTX] : (const float*)(wsb + OFF_CTXS)) + (size_t)(t - TL) * D;
}
DEV float* xrow_cur(const Params& P, int t) {
    char* const wsb = opaque_ptr(P.ws);
    if (t < TL) return P.out + (size_t)t * D;
    return (float*)(wsb + OFF_CTXS) + (size_t)(t - TL) * D;
}

#define XB_TMO      128
#define XB_XCNT(j)  (256  + 64 * (j))
#define XB_XSUB(j)  (1280 + 64 * (j))
#define XB_XGEN(j)  (2304 + 64 * (j))
#define XB_TOP      3328
#define XB_TOPGEN   3392
#define XCD_BAR_WORDS 3456
#define XB_SPIN_CAP (1u << 22)
typedef __attribute__((address_space(1))) unsigned gu32;
__device__ __forceinline__ unsigned xb_ld(gu32* p)              { return __hip_atomic_load(p, __ATOMIC_RELAXED, __HIP_MEMORY_SCOPE_AGENT); }
__device__ __forceinline__ unsigned xb_add(gu32* p, unsigned v) { return __hip_atomic_fetch_add(p, v, __ATOMIC_RELAXED, __HIP_MEMORY_SCOPE_AGENT); }
__device__ __forceinline__ unsigned xb_xcc_id() { return (unsigned)__builtin_amdgcn_s_getreg((3 << 11) | 20) & 0xFu; }
#define XB_SPIN(cond, bar) do { unsigned _sp = 0; while (cond) { __builtin_amdgcn_s_sleep(1); \
    if ((++_sp & 255u) == 0u) { if (xb_ld(&(bar)[XB_TMO])) break; if (_sp > XB_SPIN_CAP) { xb_add(&(bar)[XB_TMO], 1u); break; } } } } while (0)
struct XcdBarrier { unsigned* bar; unsigned x; volatile LAS unsigned* st; };
__device__ __forceinline__ XcdBarrier xcd_barrier_post(unsigned* bar, volatile LAS unsigned* st) {
    XcdBarrier b; b.bar = bar; b.x = xb_xcc_id(); b.st = st;
    if (plain_tid() == 0) (void)xb_add(&((gu32*)bar)[XB_XCNT(b.x)], 1u);
    return b;
}
__device__ __forceinline__ void xcd_barrier_complete(gu32* bar, unsigned x, unsigned& nloc, unsigned& nx) {
    const unsigned G = gridDim.x * gridDim.y * gridDim.z;
    unsigned sum, cnt, mine, sp = 0u;
    for (;;) {
        sum = 0u; cnt = 0u; mine = 0u;
#pragma unroll
        for (unsigned j = 0; j < 16; ++j) { const unsigned c = xb_ld(&bar[XB_XCNT(j)]); sum += c; cnt += (c > 0u) ? 1u : 0u; mine = (j == x) ? c : mine; }
        if (sum == G) break;
        __builtin_amdgcn_s_sleep(1);
        if ((++sp & 255u) == 0u) { if (xb_ld(&bar[XB_TMO])) break; if (sp > XB_SPIN_CAP) { xb_add(&bar[XB_TMO], 1u); break; } }
    }
    nloc = mine > 0u ? mine : 1u; nx = cnt > 0u ? cnt : 1u;
}
__device__ __forceinline__ void xcd_barrier(const XcdBarrier& b) {
    asm volatile("s_waitcnt vmcnt(0)" ::: "memory");
    __syncthreads();
    if (plain_tid() == 0) {
        gu32* bar = (gu32*)opaque_ptr((char*)b.bar);
        unsigned bx = b.x; asm volatile("" : "+s"(bx));
        __builtin_amdgcn_s_waitcnt(0);
        unsigned nloc = b.st[0], nx = b.st[1];
        if (nloc == 0u) { xcd_barrier_complete(bar, bx, nloc, nx); b.st[0] = nloc; b.st[1] = nx; }
        const unsigned old = xb_add(&bar[XB_XSUB(bx)], 1u);
        const unsigned gen = old / nloc;
        if (old + 1u == (gen + 1u) * nloc) {
            __builtin_amdgcn_fence(__ATOMIC_RELEASE, "agent");
            asm volatile("s_waitcnt vmcnt(0)" ::: "memory");
            const unsigned og = xb_add(&bar[XB_TOP], 1u);
            const unsigned tg = og / nx;
            if (og + 1u == (tg + 1u) * nx) xb_add(&bar[XB_TOPGEN], 1u);
            else XB_SPIN(xb_ld(&bar[XB_TOPGEN]) == tg, bar);
            __builtin_amdgcn_fence(__ATOMIC_ACQUIRE, "agent");
            xb_add(&bar[XB_XGEN(bx)], 1u);
            asm volatile("s_waitcnt vmcnt(0)" ::: "memory");
        } else {
            XB_SPIN(xb_ld(&bar[XB_XGEN(bx)]) == gen, bar);
            __builtin_amdgcn_fence(__ATOMIC_ACQUIRE, "agent");
            asm volatile("s_waitcnt vmcnt(0)" ::: "memory");
        }
    }
    __syncthreads();
}

constexpr int BK = 64, HALF = 128, HT = HALF * BK;

DEV int lds_byte(int r, int c) {
    int st = (r >> 4) * 2 + (c >> 5), rr = r & 15, cc = c & 31, ob = rr * 64 + cc * 2;
    return st * 1024 + (ob ^ (((ob >> 9) & 1) << 5));
}
DEV void stage_rc(int b, int& R, int& C) {
    int st = b / 1024, sb = b % 1024, swz = sb ^ (((sb >> 9) & 1) << 5);
    R = (st >> 1) * 16 + swz / 64; C = (st & 1) * 32 + (swz % 64) / 2;
}

template <class AOff>
DEV void gemm_tile_core(const u16* __restrict__ Abase, AOff aoffA, const u16* __restrict__ Bt, const int Kin, char* lds) {
    const int tidx = opaque_tid();
    u16* Cs = (u16*)lds;
    int K = Kin; asm volatile("" : "+s"(K));
    u16* shm = (u16*)lds;
#define SA(b, h) (shm + ((b) * 2 + (h)) * HT)
#define SB(b, h) (shm + (4 + (b) * 2 + (h)) * HT)
#define STAGE_A(TZ, P, h, kt) do { \
    for (int _i = 0; _i < 2; ++_i) { const int _b = (TZ) * 16 + _i * 8192; \
      __builtin_amdgcn_global_load_lds((const unsigned*)((const char*)Abase + (size_t)(u32)(voa[h][_i] + (u32)(kt) * (BK * 2))), \
        (LAS unsigned*)((LAS char*)(P) + _b), 16, 0, 0); } } while (0)
#define STAGE_B(TZ, P, h, kt) do { const char* _bb = (const char*)(Bt + (size_t)(h) * HALF * K); \
    for (int _i = 0; _i < 2; ++_i) { const int _b = (TZ) * 16 + _i * 8192; \
      __builtin_amdgcn_global_load_lds((const unsigned*)(_bb + (size_t)(u32)(vob[_i] + (u32)(kt) * (BK * 2))), \
        (LAS unsigned*)((LAS char*)(P) + _b), 16, 0, 0); } } while (0)
#define LDA(dst, b, h) for (int m = 0; m < 4; ++m) for (int k = 0; k < 2; ++k) \
    dst[m][k] = *reinterpret_cast<const bf16x8*>((char*)SA(b, h) + lds_byte(wr * 64 + m * 16 + fr, k * 32 + fq * 8))
#define LDB(dst, b, h) for (int n = 0; n < 2; ++n) for (int k = 0; k < 2; ++k) \
    dst[n][k] = *reinterpret_cast<const bf16x8*>((char*)SB(b, h) + lds_byte(wc * 32 + n * 16 + fr, k * 32 + fq * 8))
#define MMA(ai, bj, At, Bx) do { __builtin_amdgcn_s_setprio(1); \
    for (int m = 0; m < 4; ++m) for (int n = 0; n < 2; ++n) for (int k = 0; k < 2; ++k) \
      acc[ai][bj][m][n] = __builtin_amdgcn_mfma_f32_16x16x32_bf16(Bx[n][k], At[m][k], acc[ai][bj][m][n], 0, 0, 0); \
    __builtin_amdgcn_s_setprio(0); } while (0)
#define WAIT_V(n) asm volatile("s_waitcnt vmcnt(" #n ")" ::: "memory")
#define WAIT_L(n) asm volatile("s_waitcnt lgkmcnt(" #n ")" ::: "memory")
#define BAR __builtin_amdgcn_s_barrier()
#define SCHED __builtin_amdgcn_sched_barrier(0)
    int wid = tidx >> 6, lane = tidx & 63, wr = wid >> 2, wc = wid & 3, fr = lane & 15, fq = lane >> 4;
    u32 voa[2][2], vob[2];
    const int tz0 = opaque_tid();
    {
        for (int i = 0; i < 2; ++i) {
            int _b = tz0 * 16 + i * 8192; int _r, _c; stage_rc(_b, _r, _c);
            vob[i] = (u32)(_r * K + _c) * 2u;
            for (int h = 0; h < 2; ++h) voa[h][i] = (aoffA(h * HALF + _r) + (u32)_c) * 2u;
        }
    }
    f32x4 acc[2][2][4][2] = {};
    bf16x8 At[4][2], B0[2][2], B1[2][2];
    const int nt = K / BK;
    __syncthreads();
    STAGE_B(tidx, SB(0, 0), 0, 0); STAGE_A(tidx, SA(0, 0), 0, 0);
    STAGE_B(tidx, SB(0, 1), 1, 0); STAGE_A(tidx, SA(0, 1), 1, 0);
    if (wr == 1) BAR;
    WAIT_V(4); BAR;
    STAGE_B(tidx, SB(1, 0), 0, 1); STAGE_A(tidx, SA(1, 0), 0, 1); STAGE_B(tidx, SB(1, 1), 1, 1);
    WAIT_V(6); BAR;
    for (int t = 0; t < nt - 2; t += 2) {
        LDB(B0, 0, 0); SCHED; LDA(At, 0, 0); STAGE_A(tidx, SA(1, 1), 1, t + 1);
        WAIT_L(8); BAR; WAIT_L(0); MMA(0, 0, At, B0); BAR; SCHED;
        LDB(B1, 0, 1); STAGE_B(tidx, SB(0, 0), 0, t + 2);
        BAR; WAIT_L(0); MMA(0, 1, At, B1); BAR;
        LDA(At, 0, 1); STAGE_A(tidx, SA(0, 0), 0, t + 2);
        BAR; WAIT_L(0); MMA(1, 0, At, B0); BAR; SCHED;
        STAGE_B(tidx, SB(0, 1), 1, t + 2);
        WAIT_V(6); BAR; MMA(1, 1, At, B1); BAR;
        LDB(B0, 1, 0); SCHED; LDA(At, 1, 0); STAGE_A(tidx, SA(0, 1), 1, t + 2);
        WAIT_L(8); BAR; WAIT_L(0); MMA(0, 0, At, B0); BAR; SCHED;
        LDB(B1, 1, 1); STAGE_B(tidx, SB(1, 0), 0, t + 3);
        BAR; WAIT_L(0); MMA(0, 1, At, B1); BAR;
        LDA(At, 1, 1); STAGE_A(tidx, SA(1, 0), 0, t + 3);
        BAR; WAIT_L(0); MMA(1, 0, At, B0); BAR; SCHED;
        STAGE_B(tidx, SB(1, 1), 1, t + 3);
        WAIT_V(6); BAR; MMA(1, 1, At, B1); BAR;
    }
    int tz = tidx; asm volatile("" : "+v"(tz)); wid = tz >> 6; lane = tz & 63; wr = wid >> 2; wc = wid & 3; fr = lane & 15; fq = lane >> 4;
    { LDB(B0, 0, 0); WAIT_V(0); LDA(At, 0, 0); STAGE_A(tz, SA(1, 1), 1, nt - 1);
      BAR; WAIT_L(0); MMA(0, 0, At, B0); BAR;
      LDB(B1, 0, 1); BAR; WAIT_L(0); MMA(0, 1, At, B1); BAR;
      LDA(At, 0, 1); WAIT_V(4); BAR; WAIT_L(0); MMA(1, 0, At, B0); MMA(1, 1, At, B1); BAR; }
    { LDB(B0, 1, 0); LDA(At, 1, 0); WAIT_V(2); BAR; WAIT_L(0); MMA(0, 0, At, B0); BAR;
      LDB(B1, 1, 1); WAIT_V(0); BAR; WAIT_L(0); MMA(0, 1, At, B1); BAR;
      LDA(At, 1, 1); BAR; WAIT_L(0); MMA(1, 0, At, B0); MMA(1, 1, At, B1); BAR; }
    if (wr == 0) BAR;
    __syncthreads();
    for (int ai = 0; ai < 2; ++ai) for (int bj = 0; bj < 2; ++bj) for (int m = 0; m < 4; ++m) for (int n = 0; n < 2; ++n) {
        uint2 pk; pk.x = cvt_pk_bf16(acc[ai][bj][m][n][0], acc[ai][bj][m][n][1]); pk.y = cvt_pk_bf16(acc[ai][bj][m][n][2], acc[ai][bj][m][n][3]);
        *(uint2*)(Cs + (ai * HALF + wr * 64 + m * 16 + fr) * CS_STRIDE + (bj * HALF + wc * 32 + n * 16 + fq * 4)) = pk;
    }
    __syncthreads();
#undef SA
#undef SB
#undef STAGE_A
#undef STAGE_B
#undef LDA
#undef LDB
#undef MMA
}

struct GemmPre { const u16* Abase; const u16* Bt; u32 voa[2][2]; u32 vob[2]; int K; };
template <class AOff>
DEV void gemm_pre_make(GemmPre& g, const u16* Abase, AOff aoffA, const u16* Bt, int K) {
    const int tz0 = opaque_tid();
    g.Abase = Abase; g.Bt = Bt; g.K = K;
#pragma unroll
    for (int i = 0; i < 2; ++i) {
        int _b = tz0 * 16 + i * 8192; int _r, _c; stage_rc(_b, _r, _c);
        g.vob[i] = (u32)(_r * K + _c) * 2u;
#pragma unroll
        for (int h = 0; h < 2; ++h) g.voa[h][i] = (aoffA(h * HALF + _r) + (u32)_c) * 2u;
    }
}
#define GP_STAGE_A(G, P, h, kt) do { \
    for (int _i = 0; _i < 2; ++_i) { const int _b = tidx * 16 + _i * 8192; \
      __builtin_amdgcn_global_load_lds((const unsigned*)((const char*)(G).Abase + (size_t)(u32)((G).voa[h][_i] + (u32)(kt) * (BK * 2))), \
        (LAS unsigned*)((LAS char*)(P) + _b), 16, 0, 0); } } while (0)
#define GP_STAGE_B(G, P, h, kt) do { const char* _bb = (const char*)((G).Bt + (size_t)(h) * HALF * (G).K); \
    for (int _i = 0; _i < 2; ++_i) { const int _b = tidx * 16 + _i * 8192; \
      __builtin_amdgcn_global_load_lds((const unsigned*)(_bb + (size_t)(u32)((G).vob[_i] + (u32)(kt) * (BK * 2))), \
        (LAS unsigned*)((LAS char*)(P) + _b), 16, 0, 0); } } while (0)
DEV void gemm_pre_issue(const GemmPre& g, char* lds) {
    const int tidx = opaque_tid();
    u16* shm = (u16*)lds;
    GP_STAGE_B(g, (shm + (4 + 0) * HT), 0, 0); GP_STAGE_A(g, (shm + 0 * HT), 0, 0);
    GP_STAGE_B(g, (shm + (4 + 1) * HT), 1, 0); GP_STAGE_A(g, (shm + 1 * HT), 1, 0);
}
template <class AfterLoop, class Epi>
DEV void gemm_tile_pipe(const GemmPre& g, char* lds, AfterLoop after_loop, Epi epi) {
    const int tidx = opaque_tid();
    const u16* __restrict__ Abase = g.Abase; const u16* __restrict__ Bt = g.Bt;
    int K = g.K; asm volatile("" : "+s"(K));
    u16* shm = (u16*)lds;
#define SA(b, h) (shm + ((b) * 2 + (h)) * HT)
#define SB(b, h) (shm + (4 + (b) * 2 + (h)) * HT)
#define STAGE_A(TZ, P, h, kt) do { \
    for (int _i = 0; _i < 2; ++_i) { const int _b = (TZ) * 16 + _i * 8192; \
      __builtin_amdgcn_global_load_lds((const unsigned*)((const char*)Abase + (size_t)(u32)(voa[h][_i] + (u32)(kt) * (BK * 2))), \
        (LAS unsigned*)((LAS char*)(P) + _b), 16, 0, 0); } } while (0)
#define STAGE_B(TZ, P, h, kt) do { const char* _bb = (const char*)(Bt + (size_t)(h) * HALF * K); \
    for (int _i = 0; _i < 2; ++_i) { const int _b = (TZ) * 16 + _i * 8192; \
      __builtin_amdgcn_global_load_lds((const unsigned*)(_bb + (size_t)(u32)(vob[_i] + (u32)(kt) * (BK * 2))), \
        (LAS unsigned*)((LAS char*)(P) + _b), 16, 0, 0); } } while (0)
#define LDA(dst, b, h) for (int m = 0; m < 4; ++m) for (int k = 0; k < 2; ++k) \
    dst[m][k] = *reinterpret_cast<const bf16x8*>((char*)SA(b, h) + lds_byte(wr * 64 + m * 16 + fr, k * 32 + fq * 8))
#define LDB(dst, b, h) for (int n = 0; n < 2; ++n) for (int k = 0; k < 2; ++k) \
    dst[n][k] = *reinterpret_cast<const bf16x8*>((char*)SB(b, h) + lds_byte(wc * 32 + n * 16 + fr, k * 32 + fq * 8))
#define MMA(ai, bj, At, Bx) do { __builtin_amdgcn_s_setprio(1); \
    for (int m = 0; m < 4; ++m) for (int n = 0; n < 2; ++n) for (int k = 0; k < 2; ++k) \
      acc[ai][bj][m][n] = __builtin_amdgcn_mfma_f32_16x16x32_bf16(Bx[n][k], At[m][k], acc[ai][bj][m][n], 0, 0, 0); \
    __builtin_amdgcn_s_setprio(0); } while (0)
#define WAIT_V(n) asm volatile("s_waitcnt vmcnt(" #n ")" ::: "memory")
#define WAIT_L(n) asm volatile("s_waitcnt lgkmcnt(" #n ")" ::: "memory")
#define BAR __builtin_amdgcn_s_barrier()
#define SCHED __builtin_amdgcn_sched_barrier(0)
    int wid = tidx >> 6, lane = tidx & 63, wr = wid >> 2, wc = wid & 3, fr = lane & 15, fq = lane >> 4;
    u32 voa[2][2], vob[2];
    voa[0][0] = g.voa[0][0]; voa[0][1] = g.voa[0][1]; voa[1][0] = g.voa[1][0]; voa[1][1] = g.voa[1][1]; vob[0] = g.vob[0]; vob[1] = g.vob[1];
    f32x4 acc[2][2][4][2] = {};
    bf16x8 At[4][2], B0[2][2], B1[2][2];
    const int nt = K / BK;
    if (wr == 1) BAR;
    WAIT_V(4); BAR;
    STAGE_B(tidx, SB(1, 0), 0, 1); STAGE_A(tidx, SA(1, 0), 0, 1); STAGE_B(tidx, SB(1, 1), 1, 1);
    WAIT_V(6); BAR;
    for (int t = 0; t < nt - 2; t += 2) {
        LDB(B0, 0, 0); SCHED; LDA(At, 0, 0); STAGE_A(tidx, SA(1, 1), 1, t + 1);
        WAIT_L(8); BAR; WAIT_L(0); MMA(0, 0, At, B0); BAR; SCHED;
        LDB(B1, 0, 1); STAGE_B(tidx, SB(0, 0), 0, t + 2);
        BAR; WAIT_L(0); MMA(0, 1, At, B1); BAR;
        LDA(At, 0, 1); STAGE_A(tidx, SA(0, 0), 0, t + 2);
        BAR; WAIT_L(0); MMA(1, 0, At, B0); BAR; SCHED;
        STAGE_B(tidx, SB(0, 1), 1, t + 2);
        WAIT_V(6); BAR; MMA(1, 1, At, B1); BAR;
        LDB(B0, 1, 0); SCHED; LDA(At, 1, 0); STAGE_A(tidx, SA(0, 1), 1, t + 2);
        WAIT_L(8); BAR; WAIT_L(0); MMA(0, 0, At, B0); BAR; SCHED;
        LDB(B1, 1, 1); STAGE_B(tidx, SB(1, 0), 0, t + 3);
        BAR; WAIT_L(0); MMA(0, 1, At, B1); BAR;
        LDA(At, 1, 1); STAGE_A(tidx, SA(1, 0), 0, t + 3);
        BAR; WAIT_L(0); MMA(1, 0, At, B0); BAR; SCHED;
        STAGE_B(tidx, SB(1, 1), 1, t + 3);
        WAIT_V(6); BAR; MMA(1, 1, At, B1); BAR;
    }
    int tz = tidx; asm volatile("" : "+v"(tz)); wid = tz >> 6; lane = tz & 63; wr = wid >> 2; wc = wid & 3; fr = lane & 15; fq = lane >> 4;
    { LDB(B0, 0, 0); WAIT_V(0); LDA(At, 0, 0); STAGE_A(tz, SA(1, 1), 1, nt - 1);
      BAR; WAIT_L(0); MMA(0, 0, At, B0); BAR;
      LDB(B1, 0, 1); BAR; WAIT_L(0); MMA(0, 1, At, B1); BAR;
      LDA(At, 0, 1); WAIT_V(4); BAR; WAIT_L(0); MMA(1, 0, At, B0); MMA(1, 1, At, B1); BAR; }
    { LDB(B0, 1, 0); LDA(At, 1, 0); WAIT_V(2); BAR; WAIT_L(0); MMA(0, 0, At, B0); BAR;
      LDB(B1, 1, 1); WAIT_V(0); BAR; WAIT_L(0); MMA(0, 1, At, B1); BAR;
      LDA(At, 1, 1); BAR; WAIT_L(0); MMA(1, 0, At, B0); MMA(1, 1, At, B1); BAR; }
    if (wr == 0) BAR;
    __syncthreads();
    after_loop();
    epi(acc, wr, wc, fr, fq);
#undef SA
#undef SB
#undef STAGE_A
#undef STAGE_B
#undef LDA
#undef LDB
#undef MMA
}


DEV void convert_tile(const float* __restrict__ src, u16* __restrict__ dst, int K, int N, int mode, int tile, char* lds) {
    const int tidx = opaque_tid();
    float* tl = (float*)lds;
    const int ntn = N / 64;
    const int tk = tile / ntn, tn = tile % ntn;
    const int t = tidx;
    __syncthreads();
    {
        const int kk = t >> 4, n4 = (t & 15) * 4;
#pragma unroll
        for (int i = 0; i < 2; ++i) {
            const int k = kk + i * 32;
            const float4 v = *(const float4*)(src + (size_t)(tk * 64 + k) * N + tn * 64 + n4);
            tl[k * 65 + n4 + 0] = v.x; tl[k * 65 + n4 + 1] = v.y; tl[k * 65 + n4 + 2] = v.z; tl[k * 65 + n4 + 3] = v.w;
        }
    }
    __syncthreads();
    {
        const int n = t >> 3, k8 = (t & 7) * 8;
        float f[8];
        if (mode == 3) {
#pragma unroll
            for (int i = 0; i < 8; ++i) f[i] = tl[((k8 & 32) + (i >> 2) * 16 + ((k8 >> 3) & 3) * 4 + (i & 3)) * 65 + n];
        } else {
#pragma unroll
            for (int i = 0; i < 8; ++i) f[i] = tl[(k8 + i) * 65 + n];
        }
        const int c = tn * 64 + n;
        int row = c;
        if (mode == 1) row = (c >> 7) * 256 + (c & 127);
        else if (mode == 2) row = (c >> 7) * 256 + 128 + (c & 127);
        *(uint4*)(dst + (size_t)row * K + tk * 64 + k8) = pack8(f);
    }
}
DEV void convert_set(const float* src, size_t src_mat_stride, u16* dst, size_t dst_mat_stride, int nmat, int K, int N, int mode, int bid, int nb, char* lds) {
    const int tpm = (K / 64) * (N / 64);
    for (int i = bid; i < nmat * tpm; i += nb) {
        const int m = i / tpm, tile = i % tpm;
        convert_tile(src + (size_t)m * src_mat_stride, dst + (size_t)m * dst_mat_stride, K, N, mode, tile, lds);
    }
}

DEV void phase_init(const Params& P, int bid, int nb, char* lds) {
    char* const wsb = opaque_ptr(P.ws);
    const int tidx = opaque_tid();
    const int t = tidx;
    convert_set(P.in[I_WIN], (size_t)D * INC, (u16*)(wsb + OFF_WIN), (size_t)INC * D, 2, D, INC, 0, bid, nb, lds);
    convert_set(P.in[I_WOUT], (size_t)D * D, (u16*)(wsb + OFF_WOUT), (size_t)D * D, 2, D, D, 0, bid, nb, lds);
    convert_set(P.in[I_S5WGLU], (size_t)256 * 256, (u16*)(wsb + OFF_WGLU), (size_t)256 * 256, 2, 256, 256, 0, bid, nb, lds);
    convert_set(P.in[I_WSGATE], (size_t)D * 256, (u16*)(wsb + OFF_WSH1), (size_t)512 * D, 2, D, 256, 1, bid, nb, lds);
    convert_set(P.in[I_WSUP], (size_t)D * 256, (u16*)(wsb + OFF_WSH1), (size_t)512 * D, 2, D, 256, 2, bid, nb, lds);
    convert_set(P.in[I_WSDOWN], (size_t)256 * D, (u16*)(wsb + OFF_WSH2), (size_t)D * 256, 2, 256, D, 3, bid, nb, lds);
    __syncthreads();
    float* cond = (float*)lds;
    float* red = (float*)(lds + 9 * 1024 * 4);
    for (int i = t; i < 9 * 1024; i += NTHREADS) {
        const int r = i >> 10, k = i & 1023;
        const float v = (r < 8) ? P.in[I_C][r * 1024 + k] : P.in[I_CCTX][k];
        cond[i] = silu_f(v);
    }
    __syncthreads();
    float* mod = (float*)(wsb + OFF_MOD);
    for (int job = bid; job < 192; job += nb) {
        const int l = job / 96, n0 = (job % 96) * 64;
        const int w = t >> 6, lane = t & 63;
        float acc[9];
#pragma unroll
        for (int r = 0; r < 9; ++r) acc[r] = 0.f;
        const float* wm = P.in[I_WMOD] + (size_t)l * D * 6144 + n0 + lane;
#pragma unroll 1
        for (int k0 = w * 128; k0 < (w + 1) * 128; k0 += 16) {
            float wv[16];
#pragma unroll
            for (int kk = 0; kk < 16; ++kk) wv[kk] = wm[(size_t)(k0 + kk) * 6144];
#pragma unroll
            for (int kk = 0; kk < 16; ++kk)
#pragma unroll
                for (int r = 0; r < 9; ++r) acc[r] += cond[r * 1024 + k0 + kk] * wv[kk];
        }
#pragma unroll
        for (int r = 0; r < 9; ++r) red[(w * 9 + r) * 64 + lane] = acc[r];
        __syncthreads();
        for (int i = t; i < 9 * 64; i += NTHREADS) {
            const int r = i >> 6, ln = i & 63;
            float s = 0.f;
#pragma unroll
            for (int ww = 0; ww < 8; ++ww) s += red[(ww * 9 + r) * 64 + ln];
            mod[((size_t)l * 9 + r) * 6144 + n0 + ln] = s + P.in[I_BMOD][l * 6144 + n0 + ln];
        }
        __syncthreads();
    }
    if (bid == 0) {
        float* rope = (float*)(wsb + OFF_ROPE);
        if (t < 512) {
            const int v = t >> 3, i = t & 7;
            const float inv = powf(10000.f, -(float)i / 8.f);
            const float ang = (float)v * inv;
            rope[t] = cosf(ang);
            rope[512 + t] = sinf(ang);
        }
        if (t < 2) {
            const float* lv = P.in[I_ALAM] + t * 4 * 32;
            float s01 = 0.f, s23 = 0.f;
            for (int i = 0; i < 32; ++i) { s01 += lv[i] * lv[32 + i]; s23 += lv[64 + i] * lv[96 + i]; }
            ((float*)(wsb + OFF_MISC))[t] = expf(s01) - expf(s23) + lam_init_of(t);
        }
    }
}

DEV void conv_load(const float* __restrict__ src, int N, int k0, int n0, int tidx, float4 (&v)[8]) {
    const int kk = tidx >> 6, n4 = (tidx & 63) * 4;
#pragma unroll
    for (int i = 0; i < 8; ++i) v[i] = *(const float4*)(src + (size_t)(k0 + kk + i * 8) * N + n0 + n4);
}
DEV void conv_jobs(const Params& P, int l, int i0, int iend, int step, char* lds) {
    char* const wsb = opaque_ptr(P.ws);
    const int tidx = opaque_tid();
    float* tl = (float*)lds;
    f32x4 v[8];
    int i = i0;
    if (i >= iend) return;
    const float* src = nullptr; u16* dst = nullptr; int K = 0, N = 0, mode = 0, k0 = 0, n0 = 0;
#define CONV_LOAD() do { const int _kk = tidx >> 6, _n4 = (tidx & 63) * 4; _Pragma("unroll") for (int _i = 0; _i < 8; ++_i) v[_i] = *(const f32x4*)(src + (size_t)(k0 + _kk + _i * 8) * N + n0 + _n4); } while (0)
#define CONV_JOB(ji) do { const int _mat = (ji) >> 4, _t = (ji) & 15; const int _kind = _mat >> 6, _e = _mat & 63; \
        if (_kind < 2) { src = P.in[_kind == 0 ? I_WGATE : I_WUP] + ((size_t)l * NEXP + _e) * D * 256; dst = (u16*)(wsb + OFF_W1) + (size_t)_e * 512 * D; \
            K = D; N = 256; mode = _kind + 1; k0 = _t * 64; n0 = 0; } \
        else { src = P.in[I_WDOWN] + ((size_t)l * NEXP + _e) * 256 * D; dst = (u16*)(wsb + OFF_W2) + (size_t)_e * D * 256; \
            K = 256; N = D; mode = 0; k0 = (_t >> 2) * 64; n0 = (_t & 3) * 256; } } while (0)
    { CONV_JOB(i); CONV_LOAD(); }
    for (; i < iend; i += step) {
        __syncthreads();
        {
            const int kk = tidx >> 6, n4 = (tidx & 63) * 4;
#pragma unroll
            for (int j = 0; j < 8; ++j) *(f32x4*)(tl + (kk + j * 8) * 260 + n4) = v[j];
        }
        __syncthreads();
        u16* cdst = dst; const int cK = K, cmode = mode, ck0 = k0, cn0 = n0;
        { const int jn = (i + step < iend) ? i + step : i; CONV_JOB(jn); CONV_LOAD(); }
        {
            const int n = tidx & 255, kh = tidx >> 8;
            float f[32];
#pragma unroll
            for (int kk = 0; kk < 32; ++kk) f[kk] = tl[(kh * 32 + kk) * 260 + n];
            const int c = cn0 + n;
            int row = c;
            if (cmode == 1) row = (c >> 7) * 256 + (c & 127);
            else if (cmode == 2) row = (c >> 7) * 256 + 128 + (c & 127);
            u16* o = cdst + (size_t)row * cK + ck0 + kh * 32;
            if (cmode == 0) {
                float fp[32];
#pragma unroll
                for (int p = 0; p < 32; ++p) fp[p] = f[((p >> 2) & 1) * 16 + ((p >> 3) & 3) * 4 + (p & 3)];
#pragma unroll
                for (int j = 0; j < 4; ++j) *(uint4*)(o + j * 8) = pack8(fp + j * 8);
            } else {
#pragma unroll
                for (int j = 0; j < 4; ++j) *(uint4*)(o + j * 8) = pack8(f + j * 8);
            }
        }
    }
    __syncthreads();
#undef CONV_LOAD
#undef CONV_JOB
}
constexpr int CONV_NJOB = 192 * 16;
constexpr int CONV_Q = 8;
constexpr int cmin(int a, int b) { return a < b ? a : b; }
constexpr int INPROJ_TILES0 = 128 * 10 + 8 * 10, INPROJ_TILES1 = 128 * 10 + 8 * 7, OUTPROJ_TILES0 = 136 * 4;
constexpr int INPROJ_BUSY0 = INPROJ_TILES0 % NBLK, INPROJ_BUSY1 = INPROJ_TILES1 % NBLK, OUTPROJ_BUSY0 = OUTPROJ_TILES0 % NBLK;
constexpr int CONV_J1_0 = cmin((NBLK - INPROJ_BUSY0) * CONV_Q, CONV_NJOB), CONV_J1_1 = cmin((NBLK - INPROJ_BUSY1) * CONV_Q, CONV_NJOB);
constexpr int CONV_J2_0 = cmin(CONV_J1_0 + (NBLK - OUTPROJ_BUSY0) * CONV_Q, CONV_NJOB);
static_assert(INPROJ_BUSY0 > 0 && INPROJ_BUSY1 > 0 && OUTPROJ_BUSY0 > 0 && CONV_J2_0 <= CONV_NJOB && CONV_J1_1 <= CONV_NJOB, "conversion job split");
DEV void phase_prep(const Params& P, int l, int bid, int nb, char* lds) {
    char* const wsb = opaque_ptr(P.ws);
    const int tidx = opaque_tid();
    conv_jobs(P, l, (l == 0 ? CONV_J2_0 : CONV_J1_1) + bid, CONV_NJOB, nb, lds);
    const int w = tidx >> 6, lane = tidx & 63;
    const float* mod = (const float*)(wsb + OFF_MOD) + (size_t)l * 9 * 6144;
    const float* g = P.in[I_GMIX] + l * D;
    u16* hb = (u16*)(wsb + OFF_HBUF);
    int tk = bid * 8 + w;
    float4 v[4];
    {
        const float* xr = xrow_prev(P, l, tk < TT ? tk : 0);
#pragma unroll
        for (int i = 0; i < 4; ++i) v[i] = *(const float4*)(xr + lane * 4 + i * 256);
    }
    for (; tk < TT; tk += nb * 8) {
        float4 c4[4];
#pragma unroll
        for (int i = 0; i < 4; ++i) c4[i] = v[i];
        {
            const int tn = tk + nb * 8;
            const float* xr = xrow_prev(P, l, tn < TT ? tn : tk);
#pragma unroll
            for (int i = 0; i < 4; ++i) v[i] = *(const float4*)(xr + lane * 4 + i * 256);
        }
        const float* mrow = mod + (size_t)tok_mb(tk) * 6144;
        float ss = 0.f;
#pragma unroll
        for (int i = 0; i < 4; ++i) ss += c4[i].x * c4[i].x + c4[i].y * c4[i].y + c4[i].z * c4[i].z + c4[i].w * c4[i].w;
        ss = wave_sum(ss);
        const float rinv = rsqrtf(ss * (1.f / 1024.f) + EPS);
#pragma unroll
        for (int i = 0; i < 4; ++i) {
            const int c = lane * 4 + i * 256;
            const float4 gg = *(const float4*)(g + c);
            const float4 sh = *(const float4*)(mrow + c);
            const float4 sc = *(const float4*)(mrow + 1024 + c);
            uint2 o;
            o.x = pack2(c4[i].x * rinv * gg.x * (1.f + sc.x) + sh.x, c4[i].y * rinv * gg.y * (1.f + sc.y) + sh.y);
            o.y = pack2(c4[i].z * rinv * gg.z * (1.f + sc.z) + sh.z, c4[i].w * rinv * gg.w * (1.f + sc.w) + sh.w);
            *(uint2*)(hb + (size_t)tk * D + c) = o;
        }
    }
}

DEV void rope32(float* y, const float* rope, int row, int col) {
#pragma unroll
    for (int hf = 0; hf < 2; ++hf) {
        const int pv = hf == 0 ? row : col;
        const float* cs = rope + pv * 8;
        const float* sn = rope + 512 + pv * 8;
#pragma unroll
        for (int i = 0; i < 8; ++i) {
            const float x1 = y[hf * 16 + i], x2 = y[hf * 16 + 8 + i];
            const float c = cs[i], s = sn[i];
            y[hf * 16 + i] = x1 * c - x2 * s;
            y[hf * 16 + 8 + i] = x1 * s + x2 * c;
        }
    }
}

DEV void inproj_epilogue(const Params& P, int l, int mt, int nt_, char* lds) {
    char* const wsb = opaque_ptr(P.ws);
    const u16* Cs = (const u16*)lds;
    const int t = opaque_tid();
    const bool lat = mt < 128;
    const int b = lat ? (mt >> 4) : (mt - 128);
    const int pos0 = lat ? (mt & 15) * 256 : 0;
    const float* rope = (const float*)(wsb + OFF_ROPE);
    for (int hs = 0; hs < 2; ++hs) {
        const int c0 = nt_ * 256 + hs * 128;
        int seg, segstart;
        if (c0 < 384) { seg = 0; segstart = 0; } else if (c0 < 768) { seg = 1; segstart = 384; } else if (c0 < 1152) { seg = 2; segstart = 768; }
        else if (c0 < 1536) { seg = 3; segstart = 1152; } else if (c0 < 1920) { seg = 4; segstart = 1536; } else if (c0 < 2304) { seg = 5; segstart = 1920; }
        else { seg = 6; segstart = 2304; }
        if (seg == 3 || seg == 5) {
            const int col = t & 127, tq = t >> 7;
            const int hh = (c0 - segstart) / 64 + (col >> 6), dv = col & 63;
            u16* vt = (u16*)(wsb + (seg == 3 ? OFF_VAT : OFF_VNT)) + ((size_t)(b * 6 + hh) * 64 + dv) * NKEY + (lat ? pos0 : SEQ);
#pragma unroll
            for (int g16 = 0; g16 < 4; ++g16) {
                const int r0 = tq * 64 + g16 * 16;
                u16 v[16];
#pragma unroll
                for (int i = 0; i < 16; ++i) v[i] = Cs[(r0 + i) * CS_STRIDE + hs * 128 + col];
                uint4 q0, q1;
                q0.x = (u32)v[0] | ((u32)v[1] << 16);   q0.y = (u32)v[2] | ((u32)v[3] << 16);
                q0.z = (u32)v[8] | ((u32)v[9] << 16);   q0.w = (u32)v[10] | ((u32)v[11] << 16);
                q1.x = (u32)v[4] | ((u32)v[5] << 16);   q1.y = (u32)v[6] | ((u32)v[7] << 16);
                q1.z = (u32)v[12] | ((u32)v[13] << 16); q1.w = (u32)v[14] | ((u32)v[15] << 16);
                *(uint4*)(vt + r0) = q0;
                *(uint4*)(vt + r0 + 8) = q1;
            }
        } else {
            const int r = t >> 1, sub = t & 1;
            const int pos = pos0 + r;
            float v[64];
#pragma unroll
            for (int i = 0; i < 8; ++i) unpack8(*(const uint4*)(Cs + r * CS_STRIDE + hs * 128 + sub * 64 + i * 8), v + i * 8);
            const int hh = (c0 - segstart) / 64 + sub;
            if (seg == 0 || seg == 2) {
                const float* g = P.in[seg == 0 ? I_AGQ : I_AGK] + l * 32;
                const float qs = seg == 0 ? 0.17677669529663687f * LOG2E : 1.f;
#pragma unroll
                for (int s = 0; s < 2; ++s) {
                    float ss = 0.f;
#pragma unroll
                    for (int i = 0; i < 32; ++i) ss += v[s * 32 + i] * v[s * 32 + i];
                    const float rinv = rsqrtf(ss * (1.f / 32.f) + EPS);
#pragma unroll
                    for (int i = 0; i < 32; ++i) v[s * 32 + i] = v[s * 32 + i] * rinv * g[i];
                    if (lat) rope32(v + s * 32, rope, pos >> 6, pos & 63);
#pragma unroll
                    for (int i = 0; i < 32; ++i) v[s * 32 + i] *= qs;
                }
                if (seg == 0) {
#pragma unroll
                    for (int s = 0; s < 2; ++s) {
                        u16* dst = lat ? (u16*)(wsb + OFF_QA) + ((size_t)((b * 6 + hh) * 2 + s) * SEQ + pos) * 32
                                       : (u16*)(wsb + OFF_QAC) + ((size_t)((b * 6 + hh) * 2 + s) * LCTX + pos) * 32;
#pragma unroll
                        for (int i = 0; i < 4; ++i) *(uint4*)(dst + i * 8) = pack8(v + s * 32 + i * 8);
                    }
                } else {
                    const int key = lat ? pos : SEQ + pos;
                    u16* dst = (u16*)(wsb + OFF_KA) + ((size_t)(b * 6 + hh) * NKEY + key) * 64;
#pragma unroll
                    for (int i = 0; i < 8; ++i) *(uint4*)(dst + i * 8) = pack8(v + i * 8);
                }
            } else if (seg == 1 || seg == 4) {
                const float* g = P.in[seg == 1 ? I_NGQ : I_NGK] + l * 64;
                const float qs = seg == 1 ? 0.125f * LOG2E : 1.f;
                float ss = 0.f;
#pragma unroll
                for (int i = 0; i < 64; ++i) ss += v[i] * v[i];
                const float rinv = rsqrtf(ss * (1.f / 64.f) + EPS) * qs;
#pragma unroll
                for (int i = 0; i < 64; ++i) v[i] = v[i] * rinv * g[i];
                u16* dst;
                if (seg == 1) dst = lat ? (u16*)(wsb + OFF_QN) + ((size_t)(b * 6 + hh) * SEQ + pos) * 64 : (u16*)(wsb + OFF_QNC) + ((size_t)(b * 6 + hh) * LCTX + pos) * 64;
                else dst = (u16*)(wsb + OFF_KN) + ((size_t)(b * 6 + hh) * NKEY + (lat ? pos : SEQ + pos)) * 64;
#pragma unroll
                for (int i = 0; i < 8; ++i) *(uint4*)(dst + i * 8) = pack8(v + i * 8);
            } else {
                const int tok = mt * 256 + r;
                u16* dst = (u16*)(wsb + OFF_U) + (size_t)tok * 256 + (c0 - segstart) + sub * 64;
#pragma unroll
                for (int i = 0; i < 8; ++i) *(uint4*)(dst + i * 8) = pack8(v + i * 8);
                {
                    const int fch = lat ? 8 + (pos >> 5) : (pos >> 5), tau = pos & 31;
                    const int g0 = ((c0 - segstart) + sub * 64) >> 4;
#pragma unroll
                    for (int gi = 0; gi < 4; ++gi) {
                        u16* xd = (u16*)(wsb + OFF_XS5) + ((size_t)(g0 + gi) * 1088 + b * 136 + fch) * 768 + 256 + tau * 16;
                        *(uint4*)(xd) = pack8(v + gi * 16);
                        *(uint4*)(xd + 8) = pack8(v + gi * 16 + 8);
                    }
                }
            }
        }
    }
}

DEV void phase_inproj(const Params& P, int l, int bid, int nb, char* lds) {
    char* const wsb = opaque_ptr(P.ws);
    const bool last = (l == 1);
    const u16* A = (const u16*)(wsb + OFF_HBUF);
    const u16* W = (const u16*)(wsb + OFF_WIN) + (size_t)l * INC * D;
    const int nlat = 128 * 10;
    const int nctx = 8 * (last ? 7 : 10);
    for (int i = bid; i < nlat + nctx; i += nb) {
        int mt, nt_;
        if (i < nlat) { mt = i / 10; nt_ = i % 10; }
        else { const int j = i - nlat; if (last) { mt = 128 + j / 7; nt_ = 3 + j % 7; } else { mt = 128 + j / 10; nt_ = j % 10; } }
        const int row0 = mt * 256;
        gemm_tile_core(A, [=](int r) -> u32 { return (u32)(row0 + r) * D; }, W + (size_t)nt_ * 256 * D, D, lds);
        inproj_epilogue(P, l, mt, nt_, lds);
    }
    const int busy = last ? INPROJ_BUSY1 : INPROJ_BUSY0;
    if (nb == NBLK && bid >= busy) conv_jobs(P, l, bid - busy, last ? CONV_J1_1 : CONV_J1_0, NBLK - busy, lds);
    else if (nb != NBLK) conv_jobs(P, l, bid, last ? CONV_J1_1 : CONV_J1_0, nb, lds);
}


DEV f32x16 mfma32(bf16x8 a, bf16x8 b, f32x16 c) { return __builtin_amdgcn_mfma_f32_32x32x16_bf16(a, b, c, 0, 0, 0); }
union FragU { bf16x8 v; u32 u[4]; uint4 q; };
constexpr int KV_ROW = 144;
constexpr int KV_TILE = 64 * KV_ROW;
DEV void attnA_unit(const u16* __restrict__ q0p, const u16* __restrict__ q1p, const u16* __restrict__ kbase, const u16* __restrict__ vbase,
                    int kt0, int kt1, u16* __restrict__ outp, float lam, float li, const float* __restrict__ gsub, char* lds, int tidx_unused) {
    const int tidx = opaque_tid();
    const int w = tidx >> 6, lane = tidx & 63, r = lane & 31, hq = lane >> 5;
    FragU qf[2][2];
#pragma unroll
    for (int ks = 0; ks < 2; ++ks) {
        qf[0][ks].q = *(const uint4*)(q0p + (size_t)(w * 32 + r) * 32 + ks * 16 + hq * 8);
        qf[1][ks].q = *(const uint4*)(q1p + (size_t)(w * 32 + r) * 32 + ks * 16 + hq * 8);
    }
    f32x16 O[2][2];
#pragma unroll
    for (int s = 0; s < 2; ++s)
#pragma unroll
        for (int d = 0; d < 2; ++d)
#pragma unroll
            for (int i = 0; i < 16; ++i) O[s][d][i] = 0.f;
    float rs[2] = {0.f, 0.f};
    const int srow = tidx >> 3, schunk = tidx & 7;
    const u16* kg = kbase + (size_t)srow * 64 + schunk * 8;
    const u16* vg = vbase + (size_t)srow * NKEY + schunk * 8;
    const int soff = srow * KV_ROW + schunk * 16;
    uint4 kreg = *(const uint4*)(kg + (size_t)kt0 * 64 * 64);
    uint4 vreg = *(const uint4*)(vg + (size_t)kt0 * 64);
    __syncthreads();
    for (int t = kt0; t < kt1; ++t) {
        char* Ks = lds + ((t - kt0) & 1) * (2 * KV_TILE);
        char* Vs = Ks + KV_TILE;
        *(uint4*)(Ks + soff) = kreg;
        *(uint4*)(Vs + soff) = vreg;
        __syncthreads();
        if (t + 1 < kt1) {
            kreg = *(const uint4*)(kg + (size_t)(t + 1) * 64 * 64);
            vreg = *(const uint4*)(vg + (size_t)(t + 1) * 64);
        }
        bf16x8 vf[2][4];
#pragma unroll
        for (int d = 0; d < 2; ++d)
#pragma unroll
            for (int g = 0; g < 4; ++g) vf[d][g] = *(const bf16x8*)(Vs + (d * 32 + r) * KV_ROW + (g * 16 + hq * 8) * 2);
#pragma unroll
        for (int s = 0; s < 2; ++s) {
            FragU pf[2][2];
            bf16x8 kf4[2][2];
#pragma unroll
            for (int kt = 0; kt < 2; ++kt)
#pragma unroll
                for (int ks = 0; ks < 2; ++ks) kf4[kt][ks] = *(const bf16x8*)(Ks + (kt * 32 + r) * KV_ROW + s * 64 + ks * 32 + hq * 16);
#pragma unroll
            for (int kt = 0; kt < 2; ++kt) {
                f32x16 acc;
#pragma unroll
                for (int i = 0; i < 16; ++i) acc[i] = 0.f;
#pragma unroll
                for (int ks = 0; ks < 2; ++ks) acc = mfma32(kf4[kt][ks], qf[s][ks].v, acc);
                float p[16];
#pragma unroll
                for (int i = 0; i < 16; ++i) { p[i] = __builtin_amdgcn_exp2f(acc[i]); rs[s] += p[i]; }
#pragma unroll
                for (int s2 = 0; s2 < 2; ++s2)
#pragma unroll
                    for (int j = 0; j < 4; ++j) pf[kt][s2].u[j] = cvt_pk_bf16(p[s2 * 8 + j * 2], p[s2 * 8 + j * 2 + 1]);
            }
#pragma unroll
            for (int d = 0; d < 2; ++d)
#pragma unroll
                for (int kt = 0; kt < 2; ++kt)
#pragma unroll
                    for (int s2 = 0; s2 < 2; ++s2) O[s][d] = mfma32(vf[d][kt * 2 + s2], pf[kt][s2].v, O[s][d]);
            __builtin_amdgcn_sched_barrier(0);
        }
    }
    const float r0 = rs[0] + xor32(rs[0]), r1 = rs[1] + xor32(rs[1]);
    const float c0 = fast_rcp(r0), c1 = lam * fast_rcp(r1);
    float ss = 0.f;
#pragma unroll
    for (int d = 0; d < 2; ++d)
#pragma unroll
        for (int i = 0; i < 16; ++i) { const float o = O[0][d][i] * c0 - O[1][d][i] * c1; O[0][d][i] = o; ss += o * o; }
    ss += xor32(ss);
    const float rinv = rsqrtf(ss * (1.f / 64.f) + EPS) * (1.f - li);
    const int t2 = opaque_tid();
    const int hq2 = (t2 >> 5) & 1;
    u16* op = outp + (size_t)((t2 >> 6) * 32 + (t2 & 31)) * D;
#pragma unroll
    for (int d = 0; d < 2; ++d)
#pragma unroll
        for (int g4 = 0; g4 < 4; ++g4) {
            const int dv0 = d * 32 + 8 * g4 + 4 * hq2;
            const float4 gs = *(const float4*)(gsub + dv0);
            uint2 o;
            o.x = pack2(O[0][d][g4 * 4 + 0] * rinv * gs.x, O[0][d][g4 * 4 + 1] * rinv * gs.y);
            o.y = pack2(O[0][d][g4 * 4 + 2] * rinv * gs.z, O[0][d][g4 * 4 + 3] * rinv * gs.w);
            *(uint2*)(op + dv0) = o;
        }
}
DEV void phase_attnA(const Params& P, int l, int bid, int nb, char* lds) {
    char* const wsb = opaque_ptr(P.ws);
    const int tidx = opaque_tid();
    const bool last = (l == 1);
    const float lam = ((const float*)(wsb + OFF_MISC))[l];
    const float li = lam_init_of(l);
    const float* gsub = P.in[I_AGSUB] + l * 64;
    const int nlat = NBATCH * 6 * 16;
    const int nctx = last ? 0 : NBATCH * 6;
    for (int u = bid; u < nlat + nctx; u += nb) {
        if (u < nlat) {
            const int ux = u & 7, ui = (u >> 3);
            const int pair = ux * 6 + (ui >> 4), qb = ui & 15;
            const int b = pair / 6, h = pair % 6;
            const u16* q0p = (const u16*)(wsb + OFF_QA) + ((size_t)((b * 6 + h) * 2 + 0) * SEQ + qb * 256) * 32;
            const u16* q1p = (const u16*)(wsb + OFF_QA) + ((size_t)((b * 6 + h) * 2 + 1) * SEQ + qb * 256) * 32;
            attnA_unit(q0p, q1p, (const u16*)(wsb + OFF_KA) + (size_t)(b * 6 + h) * NKEY * 64, (const u16*)(wsb + OFF_VAT) + (size_t)(b * 6 + h) * 64 * NKEY,
                       0, NKEY / 64, (u16*)(wsb + OFF_HBUF) + (size_t)(b * SEQ + qb * 256) * D + h * 64, lam, li, gsub, lds, tidx);
        } else {
            const int j = u - nlat, b = j / 6, h = j % 6;
            const u16* q0p = (const u16*)(wsb + OFF_QAC) + ((size_t)((b * 6 + h) * 2 + 0) * LCTX) * 32;
            const u16* q1p = (const u16*)(wsb + OFF_QAC) + ((size_t)((b * 6 + h) * 2 + 1) * LCTX) * 32;
            attnA_unit(q0p, q1p, (const u16*)(wsb + OFF_KA) + (size_t)(b * 6 + h) * NKEY * 64, (const u16*)(wsb + OFF_VAT) + (size_t)(b * 6 + h) * 64 * NKEY,
                       SEQ / 64, NKEY / 64, (u16*)(wsb + OFF_HBUF) + (size_t)(TL + b * LCTX) * D + h * 64, lam, li, gsub, lds, tidx);
        }
    }
}

DEV void phase_attnN(const Params& P, int l, int bid, int nb, char* lds) {
    char* const wsb = opaque_ptr(P.ws);
    const bool last = (l == 1);
    float* part = (float*)lds;
    float* rpbs = (float*)(lds + 8 * 33 * 64 * 4);
    const int nlat = NBATCH * 6 * 16;
    const int nctx = last ? 0 : NBATCH * 6;
    for (int u = bid; u < nlat + (nctx ? nb : 0); u += nb) {
        const int tidx = opaque_tid();
        const int w = tidx >> 6, lane = tidx & 63, rl = lane & 31, hq = lane >> 5;
        if (u < nlat) {
            const int ux = u & 7, ui = (u >> 3);
            const int pair = ux * 6 + (ui >> 4), rg = ui & 15;
            const int b = pair / 6, h = pair % 6;
            const int r = rg * 4 + (w >> 1), qt = w & 1;
            const int qc = qt * 32 + rl;
            float* rpbs = (float*)(lds + 8 * KV_TILE);
            __syncthreads();
            if (tidx < 480) { const int dr_ = tidx >> 5, dc_ = tidx & 31; rpbs[tidx] = dc_ < 31 ? P.in[I_NRPB][((size_t)l * 6 + h) * 465 + dr_ * 31 + dc_] * LOG2E : -1e30f; }
            const u16* qp = (const u16*)(wsb + OFF_QN) + ((size_t)(b * 6 + h) * SEQ + r * 64 + qc) * 64;
            FragU qf[4];
#pragma unroll
            for (int ks = 0; ks < 4; ++ks) qf[ks].q = *(const uint4*)(qp + ks * 16 + hq * 8);
            const u16* kb = (const u16*)(wsb + OFF_KN) + (size_t)(b * 6 + h) * NKEY * 64;
            const u16* vb = (const u16*)(wsb + OFF_VNT) + (size_t)(b * 6 + h) * 64 * NKEY;
            const int r0 = min(max(r - 4, 0), 56), cs = min(max(qc - 8, 0), 48);
            const int r0min = min(max(rg * 4 - 4, 0), 56), r0max = min(max(rg * 4 - 1, 0), 56);
            const int nloc = r0max - r0min + 8, nst = nloc + 4;
            int bidx[2][16];
#pragma unroll
            for (int ct = 0; ct < 2; ++ct)
#pragma unroll
                for (int i2 = 0; i2 < 16; ++i2) {
                    const int kc = ct * 32 + (i2 & 3) + 8 * (i2 >> 2) + 4 * hq;
                    const bool valid = (kc >= cs) && (kc < cs + 16);
                    bidx[ct][i2] = (valid ? kc - qc + 15 : 31) * 4;
                }
            f32x16 O[2];
#pragma unroll
            for (int d = 0; d < 2; ++d)
#pragma unroll
                for (int i = 0; i < 16; ++i) O[d][i] = 0.f;
            float rs = 0.f;
            const int srow = tidx >> 3, schunk = tidx & 7;
            const int soff = srow * KV_ROW + schunk * 16;
#define NA_SKEY(st) ((st) < nloc ? (r0min + (st)) * 64 : SEQ + ((st) - nloc) * 64)
            u32x4 kreg0, vreg0, kreg1, vreg1;
            {
                const int k0_ = NA_SKEY(0), k1_ = NA_SKEY(1);
                kreg0 = *(const u32x4*)(kb + (size_t)(k0_ + srow) * 64 + schunk * 8); vreg0 = *(const u32x4*)(vb + (size_t)srow * NKEY + k0_ + schunk * 8);
                kreg1 = *(const u32x4*)(kb + (size_t)(k1_ + srow) * 64 + schunk * 8); vreg1 = *(const u32x4*)(vb + (size_t)srow * NKEY + k1_ + schunk * 8);
            }
            __syncthreads();
            for (int st = 0; st < nst; st += 2) {
                char* St = lds + ((st >> 1) & 1) * (4 * KV_TILE);
                *(u32x4*)(St + soff) = kreg0;
                *(u32x4*)(St + KV_TILE + soff) = vreg0;
                *(u32x4*)(St + 2 * KV_TILE + soff) = kreg1;
                *(u32x4*)(St + 3 * KV_TILE + soff) = vreg1;
                __syncthreads();
                if (st + 2 < nst) {
                    const int k0_ = NA_SKEY(st + 2), k1_ = NA_SKEY(st + 3 < nst ? st + 3 : st + 2);
                    kreg0 = *(const u32x4*)(kb + (size_t)(k0_ + srow) * 64 + schunk * 8); vreg0 = *(const u32x4*)(vb + (size_t)srow * NKEY + k0_ + schunk * 8);
                    kreg1 = *(const u32x4*)(kb + (size_t)(k1_ + srow) * 64 + schunk * 8); vreg1 = *(const u32x4*)(vb + (size_t)srow * NKEY + k1_ + schunk * 8);
                }
#pragma unroll 1
                for (int h2 = 0; h2 < 2; ++h2) {
                    const int sc = st + h2;
                    if (sc >= nst) break;
                    const char* Ks = St + h2 * 2 * KV_TILE;
                    const char* Vs = Ks + KV_TILE;
                    const bool local = sc < nloc;
                    const int kr = r0min + sc;
                    if (!local || (kr >= r0 && kr < r0 + 8)) {
                        const char* rrow = (const char*)rpbs + (kr - r + 7) * 128;
                        bf16x8 kf[2][4], vf[2][2][2];
#pragma unroll
                        for (int ct = 0; ct < 2; ++ct)
#pragma unroll
                            for (int ks = 0; ks < 4; ++ks) kf[ct][ks] = *(const bf16x8*)(Ks + (ct * 32 + rl) * KV_ROW + ks * 32 + hq * 16);
                        float bias[2][16];
                        if (local) {
#pragma unroll
                            for (int ct = 0; ct < 2; ++ct)
#pragma unroll
                                for (int i2 = 0; i2 < 16; ++i2) bias[ct][i2] = *(const float*)(rrow + bidx[ct][i2]);
                        } else {
#pragma unroll
                            for (int ct = 0; ct < 2; ++ct)
#pragma unroll
                                for (int i2 = 0; i2 < 16; ++i2) bias[ct][i2] = 0.f;
                        }
#pragma unroll
                        for (int ct = 0; ct < 2; ++ct)
#pragma unroll
                            for (int d = 0; d < 2; ++d)
#pragma unroll
                                for (int s2 = 0; s2 < 2; ++s2) vf[ct][d][s2] = *(const bf16x8*)(Vs + (d * 32 + rl) * KV_ROW + ((ct * 2 + s2) * 16 + hq * 8) * 2);
#pragma unroll
                        for (int ct = 0; ct < 2; ++ct) {
                            f32x16 acc;
#pragma unroll
                            for (int i2 = 0; i2 < 16; ++i2) acc[i2] = 0.f;
#pragma unroll
                            for (int ks = 0; ks < 4; ++ks) acc = mfma32(kf[ct][ks], qf[ks].v, acc);
                            float p[16];
#pragma unroll
                            for (int i2 = 0; i2 < 16; ++i2) { const float v = __builtin_amdgcn_exp2f(acc[i2] + bias[ct][i2]); p[i2] = v; rs += v; }
                            FragU pf[2];
#pragma unroll
                            for (int s2 = 0; s2 < 2; ++s2)
#pragma unroll
                                for (int j2 = 0; j2 < 4; ++j2) pf[s2].u[j2] = cvt_pk_bf16(p[s2 * 8 + j2 * 2], p[s2 * 8 + j2 * 2 + 1]);
#pragma unroll
                            for (int d = 0; d < 2; ++d)
#pragma unroll
                                for (int s2 = 0; s2 < 2; ++s2) O[d] = mfma32(vf[ct][d][s2], pf[s2].v, O[d]);
                        }
                    }
                }
            }
#undef NA_SKEY
            rs += xor32(rs);
            const float inv = fast_rcp(rs);
            u16* op = (u16*)(wsb + OFF_HBUF) + (size_t)(b * SEQ + r * 64 + qc) * D + 640 + h * 64;
#pragma unroll
            for (int d = 0; d < 2; ++d)
#pragma unroll
                for (int g4 = 0; g4 < 4; ++g4) {
                    const int dv0 = d * 32 + 8 * g4 + 4 * hq;
                    uint2 o;
                    o.x = pack2(O[d][g4 * 4 + 0] * inv, O[d][g4 * 4 + 1] * inv);
                    o.y = pack2(O[d][g4 * 4 + 2] * inv, O[d][g4 * 4 + 3] * inv);
                    *(uint2*)(op + dv0) = o;
                }
        } else {
            const int j = u - nlat - 128;
            if (j < 0 || j >= nctx) continue;
            const int b = j / 6, h = j % 6;
            const u16* qp = (const u16*)(wsb + OFF_QNC) + ((size_t)(b * 6 + h) * LCTX + w * 32 + rl) * 64;
            FragU qf[4];
#pragma unroll
            for (int ks = 0; ks < 4; ++ks) qf[ks].q = *(const uint4*)(qp + ks * 16 + hq * 8);
            const u16* kb = (const u16*)(wsb + OFF_KN) + (size_t)(b * 6 + h) * NKEY * 64;
            const u16* vb = (const u16*)(wsb + OFF_VNT) + (size_t)(b * 6 + h) * 64 * NKEY;
            f32x16 O[2];
#pragma unroll
            for (int d = 0; d < 2; ++d)
#pragma unroll
                for (int i = 0; i < 16; ++i) O[d][i] = 0.f;
            float rs = 0.f;
            u32x4 kfr[4], vfr[4], kfn[4], vfn[4];
#define NAC_LOAD(KF, VF, tile_) do { const int key0_ = SEQ + (tile_) * 32; \
                _Pragma("unroll") for (int ks = 0; ks < 4; ++ks) KF[ks] = *(const u32x4*)(kb + (size_t)(key0_ + rl) * 64 + ks * 16 + hq * 8); \
                _Pragma("unroll") for (int d = 0; d < 2; ++d) _Pragma("unroll") for (int s2 = 0; s2 < 2; ++s2) \
                    VF[d * 2 + s2] = *(const u32x4*)(vb + (size_t)(d * 32 + rl) * NKEY + key0_ + s2 * 16 + hq * 8); } while (0)
            NAC_LOAD(kfr, vfr, 0);
#pragma unroll 1
            for (int tile = 0; tile < 8; ++tile) {
                NAC_LOAD(kfn, vfn, tile + 1 < 8 ? tile + 1 : tile);
                __builtin_amdgcn_sched_barrier(0);
                f32x16 acc;
#pragma unroll
                for (int i = 0; i < 16; ++i) acc[i] = 0.f;
#pragma unroll
                for (int ks = 0; ks < 4; ++ks) acc = mfma32(__builtin_bit_cast(bf16x8, kfr[ks]), qf[ks].v, acc);
                float p[16];
#pragma unroll
                for (int i = 0; i < 16; ++i) { p[i] = __builtin_amdgcn_exp2f(acc[i]); rs += p[i]; }
                FragU pf[2];
#pragma unroll
                for (int s2 = 0; s2 < 2; ++s2)
#pragma unroll
                    for (int jj = 0; jj < 4; ++jj) pf[s2].u[jj] = cvt_pk_bf16(p[s2 * 8 + jj * 2], p[s2 * 8 + jj * 2 + 1]);
#pragma unroll
                for (int d = 0; d < 2; ++d)
#pragma unroll
                    for (int s2 = 0; s2 < 2; ++s2) O[d] = mfma32(__builtin_bit_cast(bf16x8, vfr[d * 2 + s2]), pf[s2].v, O[d]);
                __builtin_amdgcn_sched_barrier(0);
#pragma unroll
                for (int i = 0; i < 4; ++i) { kfr[i] = kfn[i]; vfr[i] = vfn[i]; }
            }
#undef NAC_LOAD
            rs += xor32(rs);
            const float inv = fast_rcp(rs);
            u16* op = (u16*)(wsb + OFF_HBUF) + (size_t)(TL + b * LCTX + w * 32 + rl) * D + 640 + h * 64;
#pragma unroll
            for (int d = 0; d < 2; ++d)
#pragma unroll
                for (int g4 = 0; g4 < 4; ++g4) {
                    const int dv0 = d * 32 + 8 * g4 + 4 * hq;
                    uint2 o;
                    o.x = pack2(O[d][g4 * 4 + 0] * inv, O[d][g4 * 4 + 1] * inv);
                    o.y = pack2(O[d][g4 * 4 + 2] * inv, O[d][g4 * 4 + 3] * inv);
                    *(uint2*)(op + dv0) = o;
                }
        }
    }
}


DEV float2 cmul(float2 a, float2 b) { return make_float2(a.x * b.x - a.y * b.y, a.x * b.y + a.y * b.x); }
DEV void s5_kf_init(const Params& P, int bid, int nb, char* lds) {
    char* const wsb = opaque_ptr(P.ws);
    const int tidx = opaque_tid();
    float2* pw = (float2*)lds;
    float2* bb = pw + 8 * 64;
    float2* cc = bb + 64 * 16;
    float* KF = (float*)(wsb + OFF_KF);
    for (int job = bid; job < 256; job += nb) {
        const int l = job >> 7, g = (job >> 3) & 15, k = (job >> 2) & 1, dq = job & 3;
        const size_t pg = (size_t)(l * 2 + k) * 16 + g;
        __syncthreads();
        {
            const int d = dq * 8 + (tidx >> 6), n = tidx & 63;
            const float are = P.in[I_S5ARE][pg * 64 + n], aim = P.in[I_S5AIM][pg * 64 + n];
            const float dt = expf(P.in[I_S5LDT][pg]);
            const float mag = expf(are * dt * (float)d), ang = aim * dt * (float)d;
            pw[tidx] = make_float2(mag * cosf(ang), mag * sinf(ang));
        }
        for (int i = tidx; i < 64 * 16; i += NTHREADS) {
            const int n = i >> 4, p = i & 15;
            const float are = P.in[I_S5ARE][pg * 64 + n], aim = P.in[I_S5AIM][pg * 64 + n];
            const float dt = expf(P.in[I_S5LDT][pg]);
            const float mag = expf(are * dt);
            const float nr = mag * cosf(aim * dt) - 1.f, ni = mag * sinf(aim * dt);
            const float den = are * are + aim * aim;
            const float2 f = make_float2((nr * are + ni * aim) / den, (ni * are - nr * aim) / den);
            bb[i] = cmul(f, make_float2(P.in[I_S5BRE][(pg * 64 + n) * 16 + p], P.in[I_S5BIM][(pg * 64 + n) * 16 + p]));
        }
        for (int i = tidx; i < 16 * 64; i += NTHREADS) {
            const int p = i >> 6, n = i & 63;
            cc[i] = make_float2(P.in[I_S5CRE][(pg * 16 + p) * 64 + n], P.in[I_S5CIM][(pg * 16 + p) * 64 + n]);
        }
        __syncthreads();
        for (int i = tidx; i < 8 * 256; i += NTHREADS) {
            const int dl = i >> 8, p = (i >> 4) & 15, q = i & 15;
            float acc = 0.f;
            for (int n = 0; n < 64; ++n) {
                const float2 t = cmul(cc[p * 64 + n], pw[dl * 64 + n]);
                const float2 b2 = bb[n * 16 + q];
                acc += t.x * b2.x - t.y * b2.y;
            }
            KF[((pg * 32) + dq * 8 + dl) * 256 + p * 16 + q] = acc;
        }
    }
}
DEV void s5_gen(const Params& P, int l, int bid, int nb, char* lds) {
    char* const wsb = opaque_ptr(P.ws);
    const int tidx = opaque_tid();
    float2* pw = (float2*)lds;
    float2* bb = pw + 2 * 33 * 64;
    float2* cc = bb + 2 * 64 * 16;
    u16* M1 = (u16*)(wsb + OFF_M1);
    u16* M3 = (u16*)(wsb + OFF_M3);
    const float* KF = (const float*)(wsb + OFF_KF);
    for (int job = bid; job < 256; job += nb) {
        const int g = job >> 4, part = job & 15;
        __syncthreads();
        for (int i = tidx; i < 2 * 33 * 64; i += NTHREADS) {
            const int k = i / (33 * 64), d = (i >> 6) % 33, n = i & 63;
            const size_t pg = (size_t)(l * 2 + k) * 16 + g;
            const float are = P.in[I_S5ARE][pg * 64 + n], aim = P.in[I_S5AIM][pg * 64 + n];
            const float dt = expf(P.in[I_S5LDT][pg]);
            const float mag = expf(are * dt * (float)d), ang = aim * dt * (float)d;
            pw[i] = make_float2(mag * cosf(ang), mag * sinf(ang));
        }
        for (int i = tidx; i < 2 * 64 * 16; i += NTHREADS) {
            const int k = i >> 10, n = (i >> 4) & 63, p = i & 15;
            const size_t pg = (size_t)(l * 2 + k) * 16 + g;
            const float are = P.in[I_S5ARE][pg * 64 + n], aim = P.in[I_S5AIM][pg * 64 + n];
            const float dt = expf(P.in[I_S5LDT][pg]);
            const float mag = expf(are * dt);
            const float nr = mag * cosf(aim * dt) - 1.f, ni = mag * sinf(aim * dt);
            const float den = are * are + aim * aim;
            const float2 f = make_float2((nr * are + ni * aim) / den, (ni * are - nr * aim) / den);
            bb[i] = cmul(f, make_float2(P.in[I_S5BRE][(pg * 64 + n) * 16 + p], P.in[I_S5BIM][(pg * 64 + n) * 16 + p]));
        }
        for (int i = tidx; i < 2 * 16 * 64; i += NTHREADS) {
            const int k = i >> 10, p = (i >> 6) & 15, n = i & 63;
            const size_t pg = (size_t)(l * 2 + k) * 16 + g;
            cc[i] = make_float2(P.in[I_S5CRE][(pg * 16 + p) * 64 + n], P.in[I_S5CIM][(pg * 16 + p) * 64 + n]);
        }
        __syncthreads();
        const float* kf0 = KF + ((size_t)(l * 2 + 0) * 16 + g) * 32 * 256;
        const float* kf1 = KF + ((size_t)(l * 2 + 1) * 16 + g) * 32 * 256;
        for (int idx = tidx; idx < 32 * 96; idx += NTHREADS) {
            const int row = part * 32 + idx / 96, c8 = (idx % 96) * 8;
            const int tau = row >> 4, p = row & 15;
            float v[8];
#pragma unroll
            for (int j = 0; j < 8; ++j) {
                const int col = c8 + j;
                if (col < 256) {
                    const int k = col >> 7, im = (col >> 6) & 1, n = col & 63;
                    const int d = (k == 0) ? tau + 1 : 32 - tau;
                    const float2 t = cmul(cc[(k * 16 + p) * 64 + n], pw[(k * 33 + d) * 64 + n]);
                    v[j] = im ? -t.y : t.x;
                } else {
                    const int sg = (col - 256) >> 4, q = col & 15;
                    float x = 0.f;
                    if (sg <= tau) x += kf0[(tau - sg) * 256 + p * 16 + q];
                    if (sg >= tau) x += kf1[(sg - tau) * 256 + p * 16 + q];
                    v[j] = x;
                }
            }
            *(uint4*)(M3 + ((size_t)g * 512 + row) * 768 + c8) = pack8(v);
        }
        for (int idx = tidx; idx < 16 * 64; idx += NTHREADS) {
            const int row = part * 16 + (idx >> 6), c8 = (idx & 63) * 8;
            const int k = row >> 7, im = (row >> 6) & 1, n = row & 63;
            float v[8];
#pragma unroll
            for (int j = 0; j < 8; ++j) {
                const int col = c8 + j, tau = col >> 4, p = col & 15;
                const int d = (k == 0) ? 31 - tau : tau;
                const float2 t = cmul(pw[(k * 33 + d) * 64 + n], bb[(k * 64 + n) * 16 + p]);
                v[j] = im ? t.y : t.x;
            }
            *(uint4*)(M1 + ((size_t)g * 256 + row) * 512 + c8) = pack8(v);
        }
    }
}
DEV void phase_s5_E(const Params& P, int l, int bid, int nb, char* lds) {
    char* const wsb = opaque_ptr(P.ws);
    const u16* X = (const u16*)(wsb + OFF_XS5);
    for (int i = bid; i < 80; i += nb) {
        const int g = i / 5, row0 = (i % 5) * 256;
        gemm_tile_core(X, [=](int r) -> u32 { return (u32)(g * 1088 + min(row0 + r, 1087)) * 768u + 256u; }, (const u16*)(wsb + OFF_M1) + (size_t)g * 256 * 512, 512, lds);
        const u16* Cs = (const u16*)lds;
        const int te = opaque_tid();
        const int r = te >> 1, ch = (te & 1) * 128;
        const int row = row0 + r;
        if (row < 1088) {
            u16* dst = (u16*)(wsb + OFF_ES5) + ((size_t)g * 1088 + row) * 256 + ch;
#pragma unroll
            for (int c = 0; c < 128; c += 8) *(uint4*)(dst + c) = *(const uint4*)(Cs + r * CS_STRIDE + ch + c);
        }
    }
}
DEV void phase_s5_carry(const Params& P, int l, int bid, int nb) {
    char* const wsb = opaque_ptr(P.ws);
    const int tidx = opaque_tid();
    if (tidx < 64) {
        const int n = tidx;
        for (int job = bid; job < 256; job += nb) {
            const int g = job >> 4, b = (job >> 1) & 7, dir = job & 1;
            const size_t pg = (size_t)(l * 2 + dir) * 16 + g;
            const float are = P.in[I_S5ARE][pg * 64 + n], aim = P.in[I_S5AIM][pg * 64 + n];
            const float dt = expf(P.in[I_S5LDT][pg]);
            const float mag = expf(are * dt * 32.f), ang = aim * dt * 32.f;
            const float ar = mag * cosf(ang), ai = mag * sinf(ang);
            const u16* E = (const u16*)(wsb + OFF_ES5) + ((size_t)g * 1088 + b * 136) * 256 + dir * 128 + n;
            u16* X = (u16*)(wsb + OFF_XS5) + ((size_t)g * 1088 + b * 136) * 768 + dir * 128 + n;
            float sr = 0.f, si = 0.f;
            for (int st0 = 0; st0 < 136; st0 += 34) {
                float er[34], ei[34];
#pragma unroll
                for (int j = 0; j < 34; ++j) {
                    const int st = st0 + j;
                    const int row = (dir == 0) ? st : (st < 8 ? 7 - st : 143 - st);
                    er[j] = bf2f(E[(size_t)row * 256]);
                    ei[j] = bf2f(E[(size_t)row * 256 + 64]);
                }
#pragma unroll
                for (int j = 0; j < 34; ++j) {
                    const int st = st0 + j;
                    const int row = (dir == 0) ? st : (st < 8 ? 7 - st : 143 - st);
                    X[(size_t)row * 768] = f2bf(sr);
                    X[(size_t)row * 768 + 64] = f2bf(si);
                    const float nr = ar * sr - ai * si + er[j];
                    const float ni = ar * si + ai * sr + ei[j];
                    sr = nr; si = ni;
                }
            }
        }
    }
}
DEV void phase_s5_Y(const Params& P, int l, int bid, int nb, char* lds) {
    char* const wsb = opaque_ptr(P.ws);
    const bool last = (l == 1);
    const u16* X = (const u16*)(wsb + OFF_XS5);
    for (int i = bid; i < 160; i += nb) {
        const int g = i / 10, row0 = ((i % 10) >> 1) * 256, nt_ = i & 1;
        gemm_tile_core(X, [=](int r) -> u32 { return (u32)(g * 1088 + min(row0 + r, 1087)) * 768u; }, (const u16*)(wsb + OFF_M3) + ((size_t)g * 512 + nt_ * 256) * 768, 768, lds);
        const u16* Cs = (const u16*)lds;
        const int te = opaque_tid();
        const int r = te >> 1, hf = te & 1;
        const int row = row0 + r;
        if (row < 1088) {
            const int b = row / 136, fch = row % 136;
            if (!(last && fch < 8)) {
                const float* dsk = P.in[I_S5D] + l * 256 + g * 16;
                float dk[16];
#pragma unroll
                for (int p = 0; p < 16; ++p) dk[p] = dsk[p];
                const int tok0 = (fch < 8 ? TL + b * LCTX + fch * 32 : b * SEQ + (fch - 8) * 32) + nt_ * 16 + hf * 8;
                const u16* up0 = (const u16*)(wsb + OFF_U) + (size_t)tok0 * 256 + g * 16;
                u32x4 uu[8][2];
#pragma unroll
                for (int tl = 0; tl < 8; ++tl) { uu[tl][0] = *(const u32x4*)(up0 + tl * 256); uu[tl][1] = *(const u32x4*)(up0 + tl * 256 + 8); }
#pragma unroll
                for (int tl = 0; tl < 8; ++tl) {
                    const int tok = tok0 + tl;
                    float y[16], u[16];
                    unpack8(*(const uint4*)(Cs + r * CS_STRIDE + hf * 128 + tl * 16), y);
                    unpack8(*(const uint4*)(Cs + r * CS_STRIDE + hf * 128 + tl * 16 + 8), y + 8);
                    unpack8(__builtin_bit_cast(uint4, uu[tl][0]), u); unpack8(__builtin_bit_cast(uint4, uu[tl][1]), u + 8);
#pragma unroll
                    for (int p = 0; p < 16; ++p) y[p] = gelu_tanh(y[p] + dk[p] * u[p]);
                    u16* gp = (u16*)(wsb + OFF_GBUF) + (size_t)tok * 256 + g * 16;
                    *(uint4*)gp = pack8(y); *(uint4*)(gp + 8) = pack8(y + 8);
                }
            }
        }
    }
}
DEV void phase_s5_glu(const Params& P, int l, int bid, int nb, char* lds) {
    char* const wsb = opaque_ptr(P.ws);
    const bool last = (l == 1);
    const int nmt = last ? 128 : 136;
    const u16* G = (const u16*)(wsb + OFF_GBUF);
    const float* bg = P.in[I_S5BGLU] + l * 256;
    const int boff = (!last && nb == NBLK) ? 48 : 0;
    for (int mt = (bid >= boff ? bid - boff : bid + nb - boff); mt < nmt; mt += nb) {
        const int row0 = mt * 256;
        gemm_tile_core(G, [=](int r) -> u32 { return (u32)(row0 + r) * 256u; }, (const u16*)(wsb + OFF_WGLU) + (size_t)l * 256 * 256, 256, lds);
        const u16* Cs = (const u16*)lds;
        const int te = opaque_tid();
        const int r = te >> 1, ch = (te & 1) * 128;
        const int tok = row0 + r;
        u16* dst = (u16*)(wsb + OFF_HBUF) + (size_t)tok * D + 384 + ch;
        u32x4 gq[16];
#pragma unroll
        for (int c8 = 0; c8 < 16; ++c8) gq[c8] = *(const u32x4*)(G + (size_t)tok * 256 + ch + c8 * 8);
#pragma unroll
        for (int c = 0; c < 128; c += 8) {
            float z[8], gv[8];
            unpack8(*(const uint4*)(Cs + r * CS_STRIDE + ch + c), z);
            unpack8(__builtin_bit_cast(uint4, gq[c >> 3]), gv);
#pragma unroll
            for (int j = 0; j < 8; ++j) z[j] = gv[j] * sigmoid_f(z[j] + bg[ch + c + j]);
            *(uint4*)(dst + c) = pack8(z);
        }
    }
}


DEV void phase_outproj(const Params& P, int l, int bid, int nb, char* lds) {
    char* const wsb = opaque_ptr(P.ws);
    const bool last = (l == 1);
    const u16* A = (const u16*)(wsb + OFF_HBUF);
    const u16* W = (const u16*)(wsb + OFF_WOUT) + (size_t)l * D * D;
    const float* mod = (const float*)(wsb + OFF_MOD) + (size_t)l * 9 * 6144;
    const int nmt = last ? 128 : 136;
    for (int i = bid; i < nmt * 4; i += nb) {
        const int mt = i >> 2, nt_ = i & 3;
        const int row0 = mt * 256;
        gemm_tile_core(A, [=](int r) -> u32 { return (u32)(row0 + r) * D; }, W + (size_t)nt_ * 256 * D, D, lds);
        const u16* Cs = (const u16*)lds;
        const int te = opaque_tid();
        const int r = te >> 1, ch = (te & 1) * 128;
        const int tok = row0 + r;
        const float* xp = xrow_prev(P, l, tok) + nt_ * 256 + ch;
        float* xo = xrow_cur(P, tok) + nt_ * 256 + ch;
        const float* gt = mod + (size_t)tok_mb(tok) * 6144 + 2048 + nt_ * 256 + ch;
#pragma unroll 8
        for (int c = 0; c < 128; c += 8) {
            float y[8]; unpack8(*(const uint4*)(Cs + r * CS_STRIDE + ch + c), y);
            const float4 x0 = *(const float4*)(xp + c), x1 = *(const float4*)(xp + c + 4);
            const float4 g0 = *(const float4*)(gt + c), g1 = *(const float4*)(gt + c + 4);
            float4 o0, o1;
            o0.x = x0.x + g0.x * y[0]; o0.y = x0.y + g0.y * y[1]; o0.z = x0.z + g0.z * y[2]; o0.w = x0.w + g0.w * y[3];
            o1.x = x1.x + g1.x * y[4]; o1.y = x1.y + g1.y * y[5]; o1.z = x1.z + g1.z * y[6]; o1.w = x1.w + g1.w * y[7];
            *(float4*)(xo + c) = o0; *(float4*)(xo + c + 4) = o1;
        }
    }
    if (!last) {
        if (nb == NBLK && bid >= OUTPROJ_BUSY0) conv_jobs(P, l, CONV_J1_0 + bid - OUTPROJ_BUSY0, CONV_J2_0, NBLK - OUTPROJ_BUSY0, lds);
        else if (nb != NBLK) conv_jobs(P, l, CONV_J1_0 + bid, CONV_J2_0, nb, lds);
    }
}

#define SPLIT8_BF16(x0, x1, hi, lo) do { u32x4 _h, _l; \
        _Pragma("unroll") for (int _p = 0; _p < 4; ++_p) { \
            const float _a = _p < 2 ? (x0)[2 * _p] : (x1)[2 * _p - 4], _b = _p < 2 ? (x0)[2 * _p + 1] : (x1)[2 * _p - 3]; \
            const u32 _hp = cvt_pk_bf16(_a, _b); \
            _h[_p] = _hp; _l[_p] = cvt_pk_bf16(_a - __uint_as_float(_hp << 16), _b - __uint_as_float(_hp & 0xFFFF0000u)); \
            __builtin_amdgcn_sched_barrier(0); } \
        hi = __builtin_bit_cast(bf16x8, _h); lo = __builtin_bit_cast(bf16x8, _l); } while (0)
DEV void phase_norm2_router(const Params& P, int l, int bid, int nb, char* lds) {
    char* const wsb = opaque_ptr(P.ws);
    const int tidx = opaque_tid();
    const bool last = (l == 1);
    const int ntok = last ? TL : TT;
    const int tpb = ntok / NBLK;
    const int w = tidx >> 6, lane = tidx & 63;
    constexpr int HLS = 1028;
    float* hl = (float*)lds;
    float* part = hl + 16 * HLS;
    int* ents = (int*)(part + 8 * 16 * 64);
    float* modl = (float*)(ents + 1088);
    const float* mod = (const float*)(wsb + OFF_MOD) + (size_t)l * 9 * 6144;
    const float* g = P.in[I_GFFN] + l * D;
    const float* wr = P.in[I_WROUTER] + (size_t)l * D * NEXP;
    const float eb = P.in[I_EBIAS][l * NEXP + lane];
    u16* hb = (u16*)(wsb + OFF_HBUF);
    int* tok_e = (int*)(wsb + OFF_TOKE);
    float* tok_w = (float*)(wsb + OFF_TOKW);
    for (int blk = bid; blk < NBLK; blk += nb) {
        const int t0 = blk * tpb;
        bf16x8 whi[4][4], wlo[4][4];
        {
            const float* qw = wr + (size_t)(w * 128 + 8 * (lane >> 4)) * NEXP + (lane & 15);
#pragma unroll
            for (int ks = 0; ks < 4; ++ks) {
                asm volatile("" : "+v"(qw));
#pragma unroll
                for (int tl4 = 0; tl4 < 4; ++tl4) {
                    const f32x4 f0 = {qw[0 * NEXP + tl4 * 16], qw[1 * NEXP + tl4 * 16], qw[2 * NEXP + tl4 * 16], qw[3 * NEXP + tl4 * 16]};
                    const f32x4 f1 = {qw[4 * NEXP + tl4 * 16], qw[5 * NEXP + tl4 * 16], qw[6 * NEXP + tl4 * 16], qw[7 * NEXP + tl4 * 16]};
                    SPLIT8_BF16(f0, f1, whi[ks][tl4], wlo[ks][tl4]);
                }
                __builtin_amdgcn_sched_barrier(0);
                qw += 32 * NEXP;
            }
        }
        const int mb0 = tok_mb(t0), mb1 = tok_mb(t0 + tpb - 1);
        for (int i = tidx; i < 2048; i += NTHREADS) {
            const int sl = i >> 10, c = i & 1023;
            const float* mrow = mod + (size_t)(sl ? mb1 : mb0) * 6144;
            modl[sl * 2048 + c] = g[c] * (1.f + mrow[4096 + c]);
            modl[sl * 2048 + 1024 + c] = mrow[3072 + c];
        }
        __syncthreads();
        f32x4 xv[2][4];
#pragma unroll
        for (int j = 0; j < 2; ++j) {
            const int tl = 2 * w + j;
            const float* xr = xrow_cur(P, t0 + (tl < tpb ? tl : 0));
#pragma unroll
            for (int i = 0; i < 4; ++i) xv[j][i] = *(const f32x4*)(xr + lane * 4 + i * 256);
        }
        for (int gcur = 0; gcur < tpb + 16; gcur += 16) {
            if (gcur > 0) {
                const int grp = gcur - 16;
            __syncthreads();
            {
                f32x4 accm[4];
#pragma unroll
                for (int tl4 = 0; tl4 < 4; ++tl4) accm[tl4] = (f32x4){0.f, 0.f, 0.f, 0.f};
                const float* hp = hl + (lane & 15) * HLS + w * 128 + 8 * (lane >> 4);
#pragma unroll
                for (int ks = 0; ks < 4; ++ks) {
                    const f32x4 x0 = *(const f32x4*)(hp + ks * 32), x1 = *(const f32x4*)(hp + ks * 32 + 4);
                    bf16x8 ahi, alo;
                    SPLIT8_BF16(x0, x1, ahi, alo);
#pragma unroll
                    for (int tl4 = 0; tl4 < 4; ++tl4) {
                        accm[tl4] = __builtin_amdgcn_mfma_f32_16x16x32_bf16(alo, whi[ks][tl4], accm[tl4], 0, 0, 0);
                        accm[tl4] = __builtin_amdgcn_mfma_f32_16x16x32_bf16(ahi, wlo[ks][tl4], accm[tl4], 0, 0, 0);
                        accm[tl4] = __builtin_amdgcn_mfma_f32_16x16x32_bf16(ahi, whi[ks][tl4], accm[tl4], 0, 0, 0);
                    }
                    __builtin_amdgcn_sched_barrier(0);
                }
#pragma unroll
                for (int tl4 = 0; tl4 < 4; ++tl4)
#pragma unroll
                    for (int r4 = 0; r4 < 4; ++r4) part[(w * 16 + 4 * (lane >> 4) + r4) * 64 + tl4 * 16 + (lane & 15)] = accm[tl4][r4];
            }
            __syncthreads();
#pragma unroll 1
            for (int j = 0; j < 2; ++j) {
                const int tl = 2 * w + j;
                if (grp + tl < tpb) {
                    const int tk = t0 + grp + tl;
                    float a = 0.f;
#pragma unroll
                    for (int ww = 0; ww < 8; ++ww) a += part[(ww * 16 + tl) * 64 + lane];
                    const float sc = sigmoid_f(a);
                    const float bi = sc + eb;
                    const float m1 = max8(bi);
                    const unsigned g8 = (unsigned)(__ballot(bi == m1) >> (lane & ~7)) & 0xFFu;
                    const int holder = (lane & ~7) + __builtin_ctz(g8);
                    float gs = m1 + max8(lane == holder ? -INFINITY : bi);
                    const int gi = lane >> 3; int grank = 0;
#pragma unroll
                    for (int jj = 0; jj < 8; ++jj) { const float o = __int_as_float(__builtin_amdgcn_readlane(__float_as_int(gs), jj * 8)); grank += (o > gs || (o == gs && jj < gi)) ? 1 : 0; }
                    const bool gsel = grank < 4;
                    const float val = gsel ? bi : -INFINITY;
                    int erank = 0;
#pragma unroll 8
                    for (int jj = 0; jj < 64; ++jj) { const float o = __int_as_float(__builtin_amdgcn_readlane(__float_as_int(val), jj)); erank += (o > val || (o == val && jj < lane)) ? 1 : 0; }
                    const bool sel = gsel && erank < 8;
                    const float wsum = wave_sum(sel ? sc : 0.f);
                    if (sel) { tok_e[(size_t)tk * 8 + erank] = lane; tok_w[(size_t)tk * 8 + erank] = sc / wsum * 2.5f; ents[(grp + tl) * 8 + erank] = lane; }
                }
            }
                    }
            if (gcur < tpb) {
                const int grp = gcur;
#pragma unroll
            for (int j = 0; j < 2; ++j) {
                const int tl = 2 * w + j;
                const int tk = t0 + grp + tl;
                if (grp + tl < tpb) {
                    const float* ml = modl + (tok_mb(tk) != mb0 ? 2048 : 0);
                    float ss = 0.f;
#pragma unroll
                    for (int i = 0; i < 4; ++i) ss += xv[j][i][0] * xv[j][i][0] + xv[j][i][1] * xv[j][i][1] + xv[j][i][2] * xv[j][i][2] + xv[j][i][3] * xv[j][i][3];
                    ss = wave_sum(ss);
                    const float rinv = rsqrtf(ss * (1.f / 1024.f) + EPS);
#pragma unroll
                    for (int i = 0; i < 4; ++i) {
                        const int c = lane * 4 + i * 256;
                        const float4 gs = *(const float4*)(ml + c);
                        const float4 sh = *(const float4*)(ml + 1024 + c);
                        float4 hv;
                        hv.x = xv[j][i][0] * rinv * gs.x + sh.x; hv.y = xv[j][i][1] * rinv * gs.y + sh.y;
                        hv.z = xv[j][i][2] * rinv * gs.z + sh.z; hv.w = xv[j][i][3] * rinv * gs.w + sh.w;
                        *(float4*)(hl + tl * HLS + c) = hv;
                        uint2 o; o.x = pack2(hv.x, hv.y); o.y = pack2(hv.z, hv.w);
                        *(uint2*)(hb + (size_t)tk * D + c) = o;
                        __builtin_amdgcn_sched_barrier(0);
                    }
                } else {
#pragma unroll
                    for (int i = 0; i < 4; ++i) *(float4*)(hl + tl * HLS + lane * 4 + i * 256) = make_float4(0.f, 0.f, 0.f, 0.f);
                }
            }
#pragma unroll
            for (int j = 0; j < 2; ++j) {
                const int tn = grp + 16 + 2 * w + j;
                const float* xr = xrow_cur(P, t0 + (tn < tpb ? tn : 0));
#pragma unroll
                for (int i = 0; i < 4; ++i) xv[j][i] = *(const f32x4*)(xr + lane * 4 + i * 256);
            }
            }
        }
        __syncthreads();
        {
            int* lpos = (int*)(wsb + OFF_LPOS) + (size_t)blk * tpb * 8;
            int run[8];
#pragma unroll
            for (int ee = 0; ee < 8; ++ee) run[ee] = 0;
            const int nent = tpb * 8;
            const unsigned long long ltmask = (1ull << lane) - 1ull;
            for (int c0 = 0; c0 < nent; c0 += 64) {
                const int idx = c0 + lane;
                const int ej = idx < nent ? ents[idx] : -1;
#pragma unroll
                for (int ee = 0; ee < 8; ++ee) {
                    const int e = w * 8 + ee;
                    const unsigned long long m = __ballot(ej == e);
                    if (ej == e) lpos[idx] = run[ee] + __popcll(m & ltmask);
                    run[ee] += __popcll(m);
                }
            }
            if (lane == 0) {
#pragma unroll
                for (int ee = 0; ee < 8; ++ee) ((int*)(wsb + OFF_CNT))[blk * NEXP + w * 8 + ee] = run[ee];
            }
        }
    }
}

DEV void phase_assign(const Params& P, int l, int bid, int nb, char* lds) {
    char* const wsb = opaque_ptr(P.ws);
    const int tidx = opaque_tid();
    const int ntok = (l == 1) ? TL : TT;
    const int tpb = ntok / NBLK;
    int* s_base = (int*)lds;
    int* s_tot = s_base + 64;
    int* s_n0 = s_tot + 64;
    int* s_off = s_n0 + 64;
    int* s_ub = s_off + 65;
    const int* tok_e = (const int*)(wsb + OFF_TOKE);
    const float* tok_w = (const float*)(wsb + OFF_TOKW);
    const int* lpos = (const int*)(wsb + OFF_LPOS);
    const int* cnt = (const int*)(wsb + OFF_CNT);
    int* rowslot = (int*)(wsb + OFF_ROWSLOT);
    float* rowgate = (float*)(wsb + OFF_ROWGATE);
    int* tile_e = (int*)(wsb + OFF_TILEE);
    int* ulist = (int*)(wsb + OFF_ULIST);
    for (int blk = bid; blk < NBLK; blk += nb) {
        __syncthreads();
        {
            int* s_part = s_ub + 2 * 65;
            const int e = tidx & 63, part = tidx >> 6;
            int base = 0, tot = 0, n0 = 0;
#pragma unroll 8
            for (int b2 = part * 32; b2 < part * 32 + 32; ++b2) { const int c = cnt[b2 * NEXP + e]; if (b2 < blk) base += c; if (b2 < NBLK / NPASS) n0 += c; tot += c; }
            s_part[(part * 3 + 0) * 64 + e] = base; s_part[(part * 3 + 1) * 64 + e] = tot; s_part[(part * 3 + 2) * 64 + e] = n0;
            __syncthreads();
            if (tidx < NEXP) {
                int b_ = 0, t_ = 0, n_ = 0;
#pragma unroll
                for (int p2 = 0; p2 < 8; ++p2) { b_ += s_part[(p2 * 3 + 0) * 64 + tidx]; t_ += s_part[(p2 * 3 + 1) * 64 + tidx]; n_ += s_part[(p2 * 3 + 2) * 64 + tidx]; }
                s_base[tidx] = b_; s_tot[tidx] = t_; s_n0[tidx] = n_;
            }
        }
        __syncthreads();
        if (tidx == 0) { int run = 0; for (int e = 0; e < NEXP; ++e) { s_off[e] = run; run += (s_tot[e] + 255) & ~255; } s_off[NEXP] = run; }
        __syncthreads();
        for (int i = tidx; i < tpb * 8; i += NTHREADS) {
            const size_t gi = (size_t)blk * tpb * 8 + i;
            const int e = tok_e[gi];
            const int pos = s_off[e] + s_base[e] + lpos[gi];
            const int tk = blk * tpb + (i >> 3);
            rowslot[pos] = tk * 9 + (i & 7);
            rowgate[pos] = tok_w[gi];
        }
        if (blk < NEXP) {
            const int e = blk;
            const int p0 = s_off[e] + s_tot[e], p1 = s_off[e + 1];
            for (int p = p0 + tidx; p < p1; p += NTHREADS) { rowslot[p] = -1; rowgate[p] = 0.f; }
        }
        if (blk == 0) {
            if (tidx < NEXP) { const int e = tidx; for (int tl = s_off[e] >> 8; tl < (s_off[e + 1] >> 8); ++tl) tile_e[tl] = e; }
            if (tidx == 0) tile_e[1279] = s_off[NEXP] >> 8;
            __syncthreads();
            if (tidx < 2) {
                const int h = tidx; int run = 0;
                for (int e = 0; e < NEXP; ++e) {
                    const int lo = s_off[e] + (h ? s_n0[e] : 0), hi = s_off[e] + (h ? s_tot[e] : s_n0[e]);
                    s_ub[h * 65 + e] = run;
                    if (hi > lo) run += ((hi - 1) >> 8) - (lo >> 8) + 1;
                }
                s_ub[h * 65 + NEXP] = run;
                ulist[h * 1536 + 1535] = run;
            }
            __syncthreads();
            if (tidx < 128) {
                const int h = tidx >> 6, e = tidx & 63;
                const int lo = s_off[e] + (h ? s_n0[e] : 0), hi = s_off[e] + (h ? s_tot[e] : s_n0[e]);
                if (hi > lo) { int o = s_ub[h * 65 + e]; for (int uu = lo >> 8; uu <= ((hi - 1) >> 8); ++uu) ulist[h * 1536 + o++] = uu; }
            }
        }
    }
}

DEV void phase_gemm1(const Params& P, int l, int bid, int nb, char* lds) {
    char* const wsb = opaque_ptr(P.ws);
    const int ntok = (l == 1) ? TL : TT;
    const int* tile_e = (const int*)(wsb + OFF_TILEE);
    const int nrt = tile_e[1279];
    const int nst = ntok / 256;
    const int* rowslot = (const int*)(wsb + OFF_ROWSLOT);
    const u16* A = (const u16*)(wsb + OFF_HBUF);
    const int nun = (nrt + nst) * 2, per8 = (nun + 7) >> 3;
    const int ubase = (bid & 7) * per8, ustep = nb >> 3;
    const float* rowgate = (const float*)(wsb + OFF_ROWGATE);
    const int et = opaque_tid();
    const int erow = ((et >> 6) >> 2) * 64 + (et & 15);
#define G1_GATES(i, gs0, gs1) do { const int _mt = (i) >> 1; \
        if (_mt < nrt) { const float* _gp = rowgate + _mt * 256 + erow; \
            gs0 = (f32x4){_gp[0] * 32.f, _gp[16] * 32.f, _gp[32] * 32.f, _gp[48] * 32.f}; \
            gs1 = (f32x4){_gp[HALF] * 32.f, _gp[HALF + 16] * 32.f, _gp[HALF + 32] * 32.f, _gp[HALF + 48] * 32.f}; } \
        else { gs0 = (f32x4){1.f, 1.f, 1.f, 1.f}; gs1 = gs0; } } while (0)
    auto setup = [&](int i, GemmPre& g, u16*& dst) {
        const int mt = i >> 1, nt_ = i & 1;
        if (mt < nrt) {
            const int e = tile_e[mt];
            const int* rs = rowslot + mt * 256;
            gemm_pre_make(g, A, [=](int r) -> u32 { const int sl = rs[r]; return (u32)(sl < 0 ? 0 : sl / 9) * D; }, (const u16*)(wsb + OFF_W1) + ((size_t)e * 512 + nt_ * 256) * D, D);
            dst = (u16*)(wsb + OFF_ACT) + (size_t)mt * 256 * 256 + nt_ * 128;
        } else {
            const int row0 = (mt - nrt) * 256;
            gemm_pre_make(g, A, [=](int r) -> u32 { return (u32)(row0 + r) * D; }, (const u16*)(wsb + OFF_WSH1) + ((size_t)l * 512 + nt_ * 256) * D, D);
            dst = (u16*)(wsb + OFF_ACTSH) + (size_t)row0 * 256 + nt_ * 128;
        }
    };
    int uu = bid >> 3;
    GemmPre cur; u16* cdst = nullptr; f32x4 cg0 = {1.f, 1.f, 1.f, 1.f}, cg1 = {1.f, 1.f, 1.f, 1.f};
    bool have = (uu < per8) && (ubase + uu < nun);
    if (have) { setup(ubase + uu, cur, cdst); G1_GATES(ubase + uu, cg0, cg1); __syncthreads(); gemm_pre_issue(cur, lds); }
    while (have) {
        const int un = uu + ustep;
        const bool have_n = (un < per8) && (ubase + un < nun);
        GemmPre nxt; u16* ndst = nullptr;
        if (have_n) setup(ubase + un, nxt, ndst);
        u16* const dst = cdst; const f32x4 g0v = cg0, g1v = cg1;
        gemm_tile_pipe(cur, lds,
            [&]() { if (have_n) gemm_pre_issue(nxt, lds); },
            [&](f32x4 (&acc)[2][2][4][2], int wr, int wc, int fr, int fq) {
#pragma unroll
                for (int ai = 0; ai < 2; ++ai)
#pragma unroll
                    for (int m = 0; m < 4; ++m) {
                        const float gsc = ai == 0 ? g0v[m] : g1v[m];
                        u32x4 pk;
#pragma unroll
                        for (int n = 0; n < 2; ++n) {
                            float o[4];
#pragma unroll
                            for (int jj = 0; jj < 4; ++jj) o[jj] = silu_f(acc[ai][0][m][n][jj]) * acc[ai][1][m][n][jj] * gsc;
                            pk[n * 2] = cvt_pk_bf16(o[0], o[1]); pk[n * 2 + 1] = cvt_pk_bf16(o[2], o[3]);
                        }
                        *(u32x4*)(dst + (size_t)(ai * HALF + wr * 64 + m * 16 + fr) * 256 + wc * 32 + fq * 8) = pk;
                    }
            });
        if (have_n) G1_GATES(ubase + un, cg0, cg1);
        cur = nxt; cdst = ndst; uu = un; have = have_n;
    }
#undef G1_GATES
}

DEV void phase_gemm2(const Params& P, int l, int hx, int bid, int nb, char* lds) {
    char* const wsb = opaque_ptr(P.ws);
    const int ntok = (l == 1) ? TL : TT;
    const int nhalf = ntok / NPASS;
    const int* tile_e = (const int*)(wsb + OFF_TILEE);
    const int* ulist = (const int*)(wsb + OFF_ULIST) + hx * 1536;
    const int n_ru = ulist[1535];
    const int nst = nhalf / 256;
    const int* rowslot = (const int*)(wsb + OFF_ROWSLOT);
    unsigned char* yk = (unsigned char*)(wsb + OFF_YK);
#define G2_WAIT(n) asm volatile("s_waitcnt vmcnt(" #n ")" ::: "memory")
    const int nun = n_ru + nst, per8 = (nun + 7) >> 3;
    const int ustep = nb >> 3, u0 = (bid & 7) * per8 + (bid >> 3);
    int nk = 0;
    {
        int lim = nun - (bid & 7) * per8; if (lim > per8) lim = per8;
        const int first = bid >> 3;
        if (first < lim) nk = (lim - first + ustep - 1) / ustep;
    }
    if (nk == 0) return;
    const int total = nk * 16;
    const int tidx = opaque_tid();
    const int w = tidx >> 6, lane = tidx & 63, fr = lane & 15, fq = lane >> 4, wr = w >> 1, wc = w & 1;
    const int prow = tidx >> 5, pch = tidx & 31;
    const u16* const W2b = (const u16*)(wsb + OFF_W2);
    const u16* const WSb = (const u16*)(wsb + OFF_WSH2) + (size_t)l * D * 256;
    int* const s_u = (int*)(lds + 4 * 32768);
    __syncthreads();
    if (tidx < 16 && tidx < nk) {
        const int u = u0 + tidx * ustep;
        if (u < n_ru) { const int t = ulist[u]; s_u[2 * tidx] = t; s_u[2 * tidx + 1] = tile_e[t]; }
        else { s_u[2 * tidx] = -1 - (u - n_ru); s_u[2 * tidx + 1] = 64; }
    }
    __syncthreads();
#define G2_UNIT_E(k) __builtin_amdgcn_readfirstlane(s_u[2 * (k) + 1])
#define G2_UNIT_BT(k) (G2_UNIT_E(k) < 64 ? W2b + (size_t)G2_UNIT_E(k) * D * 256 : WSb)
    const u16* BtL = G2_UNIT_BT(0);
#define G2_ISSUE(gi) do { const int _c = (gi) & 15; \
        const u16* _s0 = BtL + (size_t)((_c >> 1) * 128 + (prow >> 2) * 16 + (_c & 1) * 8 + (prow & 3)) * 256 + ((pch ^ prow) * 8); \
        _Pragma("unroll") for (int ps = 0; ps < 4; ++ps) \
            __builtin_amdgcn_global_load_lds((const unsigned*)(_s0 + (size_t)((ps >> 1) * 64 + (ps & 1) * 4) * 256), \
                (LAS unsigned*)((LAS char*)lds + ((gi) & 3) * 32768 + ps * 8192 + tidx * 16), 16, 0, 0); } while (0)
    G2_ISSUE(0); G2_ISSUE(1); G2_ISSUE(2);
    bf16x8 af[4][8];
    u32 yo[4];
    bool routed = true;
#define G2_UNIT_SETUP(k) do { \
        const int ut = __builtin_amdgcn_readfirstlane(s_u[2 * (k)]); \
        routed = ut >= 0; \
        const int su = -1 - ut;                         \
        const u16* A; int urow; \
        if (routed) { urow = ut * 256; A = (const u16*)(wsb + OFF_ACT) + (size_t)urow * 256; } \
        else { urow = hx * nhalf + su * 256; A = (const u16*)(wsb + OFF_ACTSH) + (size_t)urow * 256; } \
        const u16* ap = A + (size_t)(wr * 64 + fr) * 256 + fq * 8; \
        _Pragma("unroll") for (int m = 0; m < 4; ++m) _Pragma("unroll") for (int ks = 0; ks < 8; ++ks) \
            af[m][ks] = *reinterpret_cast<const bf16x8*>(ap + m * 16 * 256 + ks * 32); \
        _Pragma("unroll") for (int m = 0; m < 4; ++m) { \
            const int R = wr * 64 + m * 16 + fr; int slot; \
            if (routed) { const int sl = rowslot[urow + R]; const int ls = sl - hx * nhalf * 9; \
                slot = (sl < 0 || ls < 0 || ls >= nhalf * 9) ? nhalf * 9 : ls; }     \
            else slot = (su * 256 + R) * 9 + 8; \
              \
            const int tl9 = slot / 9, k9 = slot - tl9 * 9; \
            yo[m] = (u32)tl9 * 10240u + (u32)k9 * 1024u + (u32)(routed ? (wc * 64 + fq * 16) : (wc * 64 + fq * 16) * 2); } \
          \
        asm volatile("" :: "v"(af[0][0]), "v"(af[0][1]), "v"(af[0][2]), "v"(af[0][3]), "v"(af[0][4]), "v"(af[0][5]), "v"(af[0][6]), "v"(af[0][7]), \
                           "v"(af[1][0]), "v"(af[1][1]), "v"(af[1][2]), "v"(af[1][3]), "v"(af[1][4]), "v"(af[1][5]), "v"(af[1][6]), "v"(af[1][7])); \
        asm volatile("" :: "v"(af[2][0]), "v"(af[2][1]), "v"(af[2][2]), "v"(af[2][3]), "v"(af[2][4]), "v"(af[2][5]), "v"(af[2][6]), "v"(af[2][7]), \
                           "v"(af[3][0]), "v"(af[3][1]), "v"(af[3][2]), "v"(af[3][3]), "v"(af[3][4]), "v"(af[3][5]), "v"(af[3][6]), "v"(af[3][7])); } while (0)
#define G2_BREAD(dst, gi, n, kh) do { const char* _bb = lds + ((gi) & 3) * 32768 + (wc * 32 + (n) * 16 + fr) * 512; \
        _Pragma("unroll") for (int k4 = 0; k4 < 4; ++k4) dst[k4] = *reinterpret_cast<const bf16x8*>(_bb + (((((kh) * 4 + k4) * 4 + fq) ^ fr) * 16)); } while (0)
#define G2_MMA(accv, bv, kh) do { _Pragma("unroll") for (int k4 = 0; k4 < 4; ++k4) _Pragma("unroll") for (int m = 0; m < 4; ++m) \
        accv[m] = __builtin_amdgcn_mfma_f32_16x16x32_bf16(bv[k4], af[m][(kh) * 4 + k4], accv[m], 0, 0, 0); } while (0)
    G2_UNIT_SETUP(0);
    G2_WAIT(0);
    __builtin_amdgcn_s_barrier();
    G2_ISSUE(3);
    bf16x8 bX[4], bY[4];
    G2_BREAD(bX, 0, 0, 0);
#define G2_PK8(dst, accv) do { \
        const float v0 = __builtin_amdgcn_fmed3f(accv[0], -440.f, 440.f), v1 = __builtin_amdgcn_fmed3f(accv[1], -440.f, 440.f); \
        const float v2 = __builtin_amdgcn_fmed3f(accv[2], -440.f, 440.f), v3 = __builtin_amdgcn_fmed3f(accv[3], -440.f, 440.f); \
        int pk = __builtin_amdgcn_cvt_pk_fp8_f32(v0, v1, 0, false); \
        pk = __builtin_amdgcn_cvt_pk_fp8_f32(v2, v3, pk, true); dst = (u32)pk; } while (0)
#pragma unroll 1
    for (int gp = 0; gp < total / 2; ++gp) {
        const int p = gp & 7;
        u32 pkq[4][4];
#pragma unroll
        for (int ci = 0; ci < 2; ++ci) {
            const int g = gp * 2 + ci;
            u32 sh[4][2];
            {
                f32x4 acc0[4] = {};
                __builtin_amdgcn_s_waitcnt(0xC07F);
                G2_BREAD(bY, g, 0, 1);
                __builtin_amdgcn_sched_barrier(0);
                G2_MMA(acc0, bX, 0);
                __builtin_amdgcn_sched_barrier(0);
                G2_BREAD(bX, g, 1, 0);
                __builtin_amdgcn_s_waitcnt(0xC47F);
                asm volatile("s_nop 0");
                __builtin_amdgcn_sched_barrier(0);
                G2_MMA(acc0, bY, 1);
                __builtin_amdgcn_sched_barrier(0);
                if (routed) {
#pragma unroll
                    for (int m = 0; m < 4; ++m) G2_PK8(pkq[m][ci * 2], acc0[m]);
                } else {
#pragma unroll
                    for (int m = 0; m < 4; ++m) { sh[m][0] = cvt_pk_bf16(acc0[m][0], acc0[m][1]); sh[m][1] = cvt_pk_bf16(acc0[m][2], acc0[m][3]); }
                }
                __builtin_amdgcn_sched_barrier(0);
            }
            f32x4 acc1[4] = {};
            __builtin_amdgcn_s_waitcnt(0xC07F);
            G2_BREAD(bY, g, 1, 1);
            __builtin_amdgcn_sched_barrier(0);
            G2_MMA(acc1, bX, 0);
            __builtin_amdgcn_sched_barrier(0);
            __builtin_amdgcn_s_waitcnt(0xC07F);
            asm volatile("s_nop 0");
            if (g + 1 < total) {
                if (g + 3 >= total) G2_WAIT(0);
                else if (ci == 0 && g >= 4) G2_WAIT(16);
                else G2_WAIT(12);
                asm volatile("s_waitcnt lgkmcnt(0)" ::: "memory");
                __builtin_amdgcn_s_barrier();
                if (g + 4 < total) {
                    if (((g + 4) & 15) == 0) BtL = G2_UNIT_BT((g + 4) >> 4);
                    G2_ISSUE(g + 4);
                }
                G2_BREAD(bX, g + 1, 0, 0);
                __builtin_amdgcn_sched_barrier(0);
            }
            G2_MMA(acc1, bY, 1);
            __builtin_amdgcn_sched_barrier(0);
            if (!routed) {
#pragma unroll
                for (int m = 0; m < 4; ++m) {
                    u32x4 s0 = {sh[m][0], sh[m][1], cvt_pk_bf16(acc1[m][0], acc1[m][1]), cvt_pk_bf16(acc1[m][2], acc1[m][3])};
                    *(u32x4*)(yk + yo[m] + p * 256 + ci * 16) = s0;
                }
            } else {
#pragma unroll
                for (int m = 0; m < 4; ++m) G2_PK8(pkq[m][ci * 2 + 1], acc1[m]);
            }
        }
        if (routed) {
#pragma unroll
            for (int m = 0; m < 4; ++m) {
                u32x4 s0 = {pkq[m][0], pkq[m][1], pkq[m][2], pkq[m][3]};
                *(u32x4*)(yk + yo[m] + p * 128) = s0;
            }
        }
        if (p == 7 && gp + 1 < total / 2) G2_UNIT_SETUP((gp + 1) >> 3);
    }
#undef G2_UNIT_SETUP
#undef G2_PK8
#undef G2_BREAD
#undef G2_MMA
    asm volatile("s_waitcnt lgkmcnt(0)" ::: "memory");
    __builtin_amdgcn_s_barrier();
#undef G2_ISSUE
#undef G2_UNIT_BT
#undef G2_UNIT_E
#undef G2_WAIT
}

DEV void phase_combine(const Params& P, int l, int hx, int bid, int nb) {
    char* const wsb = opaque_ptr(P.ws);
    const int tidx = opaque_tid();
    const int ntok = (l == 1) ? TL : TT;
    const int nhalf = ntok / NPASS;
    const float* mod = (const float*)(wsb + OFF_MOD) + (size_t)l * 9 * 6144;
    const u16* yk = (const u16*)(wsb + OFF_YK);
    const int sub = tidx & 127;
    for (int tl = bid * 4 + (tidx >> 7); tl < nhalf; tl += nb * 4) {
        const int tk = hx * nhalf + tl;
        float acc[8];
#pragma unroll
        for (int j = 0; j < 8; ++j) acc[j] = 0.f;
#if YK_FP8
        typedef float f2v __attribute__((ext_vector_type(2)));
#pragma unroll
        for (int k = 0; k < 8; ++k) {
            const uint2 q = *(const uint2*)((const unsigned char*)yk + (size_t)tl * 10240 + k * 1024 + sub * 8);
            const f2v a0 = __builtin_amdgcn_cvt_pk_f32_fp8((int)q.x, false), a1 = __builtin_amdgcn_cvt_pk_f32_fp8((int)q.x, true);
            const f2v a2 = __builtin_amdgcn_cvt_pk_f32_fp8((int)q.y, false), a3 = __builtin_amdgcn_cvt_pk_f32_fp8((int)q.y, true);
            acc[0] += a0[0]; acc[1] += a0[1]; acc[2] += a1[0]; acc[3] += a1[1];
            acc[4] += a2[0]; acc[5] += a2[1]; acc[6] += a3[0]; acc[7] += a3[1];
        }
        {
            float ys[8]; unpack8(*(const uint4*)((const unsigned char*)yk + (size_t)tl * 10240 + 8192 + sub * 16), ys);
#pragma unroll
            for (int j = 0; j < 8; ++j) acc[j] = acc[j] * (1.f / 32.f) + ys[j];
        }
#else
#pragma unroll
        for (int k = 0; k < 9; ++k) {
            float y[8]; unpack8(*(const uint4*)(yk + ((size_t)tl * 9 + k) * D + sub * 8), y);
#pragma unroll
            for (int j = 0; j < 8; ++j) acc[j] += y[j];
        }
#endif
        float* xr = xrow_cur(P, tk) + sub * 8;
        const float* gt = mod + (size_t)tok_mb(tk) * 6144 + 5120 + sub * 8;
        float4 x0 = *(const float4*)xr, x1 = *(const float4*)(xr + 4);
        const float4 g0 = *(const float4*)gt, g1 = *(const float4*)(gt + 4);
        x0.x += g0.x * acc[0]; x0.y += g0.y * acc[1]; x0.z += g0.z * acc[2]; x0.w += g0.w * acc[3];
        x1.x += g1.x * acc[4]; x1.y += g1.y * acc[5]; x1.z += g1.z * acc[6]; x1.w += g1.w * acc[7];
        *(float4*)xr = x0; *(float4*)(xr + 4) = x1;
    }
}

typedef __attribute__((address_space(4))) const char k4char;
DEV const Params& kparams() {
    k4char* p = (k4char*)__builtin_amdgcn_kernarg_segment_ptr();
    asm volatile("" : "+s"(p));
    return *(const Params*)p;
}
enum { PH_INIT = 0, PH_PREP, PH_INPROJ, PH_ATTNA, PH_ATTNN, PH_S5SCAN, PH_S5READ, PH_OUTPROJ, PH_NORM2, PH_COUNT, PH_ASSIGN, PH_GEMM1, PH_GEMM2, PH_COMBINE, PH_POISON };

template <int PH>
__global__ void __launch_bounds__(NTHREADS, 2) k_phase(Params P) {
    extern __shared__ __attribute__((aligned(16))) char lds[];
    const int bid = blockIdx.x, nb = gridDim.x, l = P.layer, q = P.sub;
    (void)l; (void)q; (void)lds;
#if !ONE_LAUNCH
    if (PH == PH_INIT) phase_init(P, bid, nb, lds);
    if (PH == PH_PREP) phase_prep(P, l, bid, nb, lds);
    if (PH == PH_INPROJ) phase_inproj(P, l, bid, nb, lds);
#if NAIVE_ATTN
    if (PH == PH_ATTNA) phase_attnA_naive(P, l, bid, nb);
    if (PH == PH_ATTNN) phase_attnN_naive(P, l, bid, nb);
#else
    if (PH == PH_ATTNA) phase_attnA(P, l, bid, nb, lds);
    if (PH == PH_ATTNN) phase_attnN(P, l, bid, nb, lds);
#endif
#if NAIVE_S5
    if (PH == PH_S5SCAN) phase_s5_scan_naive(P, l, bid, nb);
    if (PH == PH_S5READ) phase_s5_readout_naive(P, l, bid, nb, lds);
#endif
    if (PH == PH_OUTPROJ) phase_outproj(P, l, bid, nb, lds);
    if (PH == PH_NORM2) phase_norm2_router(P, l, bid, nb, lds);
    if (PH == PH_ASSIGN) phase_assign(P, l, bid, nb, lds);
    if (PH == PH_GEMM1) phase_gemm1(P, l, bid, nb, lds);
    if (PH == PH_GEMM2) phase_gemm2(P, l, q, bid, nb, lds);
    if (PH == PH_COMBINE) phase_combine(P, l, q, bid, nb);
#endif
    if (PH == PH_POISON) { for (size_t i = (size_t)bid * NTHREADS + threadIdx.x; i < (size_t)TL * D; i += (size_t)nb * NTHREADS) P.out[i] = __uint_as_float(0x7FC00000u); }
}


#if ONE_LAUNCH
__global__ void __launch_bounds__(NTHREADS, 2) k_mega(Params Pin) {
    extern __shared__ __attribute__((aligned(16))) char lds[];
    if (threadIdx.x == 0) *(uint4*)(lds + LDS_BYTES - 16) = make_uint4(0u, 0u, 0u, 0u);
    if ((threadIdx.x & 63) == 0) ((volatile LAS unsigned char*)(LAS char*)lds)[LDS_TID_TABLE + hw_wave_slot()] = (unsigned char)(threadIdx.x >> 6);
    __syncthreads();
    XcdBarrier bar = xcd_barrier_post((unsigned*)(kparams().ws + OFF_BAR), (volatile LAS unsigned*)(LAS char*)(lds + LDS_BYTES - 16));
    phase_init(kparams(), opaque_s((int)blockIdx.x), opaque_s((int)gridDim.x), lds);
    s5_kf_init(kparams(), opaque_s((int)blockIdx.x), opaque_s((int)gridDim.x), lds);
    xcd_barrier(bar);
#define RUN(id, stmt) do { stmt; if (REPEAT_PH == (id)) { xcd_barrier(bar); stmt; } } while (0)
    for (int l = 0; l < 2; ++l) {
        RUN(1, { phase_prep(kparams(), l, opaque_s((int)blockIdx.x), opaque_s((int)gridDim.x), lds); s5_gen(kparams(), l, opaque_s((int)blockIdx.x), opaque_s((int)gridDim.x), lds); });
        xcd_barrier(bar);
        RUN(2, phase_inproj(kparams(), l, opaque_s((int)blockIdx.x), opaque_s((int)gridDim.x), lds));
        xcd_barrier(bar);
        RUN(3, { phase_s5_E(kparams(), l, opaque_s((int)blockIdx.x), opaque_s((int)gridDim.x), lds); phase_attnN(kparams(), l, opaque_s((int)blockIdx.x), opaque_s((int)gridDim.x), lds); });
        xcd_barrier(bar);
        RUN(4, phase_s5_carry(kparams(), l, opaque_s((int)blockIdx.x), opaque_s((int)gridDim.x)));
        xcd_barrier(bar);
        RUN(5, phase_s5_Y(kparams(), l, opaque_s((int)blockIdx.x), opaque_s((int)gridDim.x), lds));
        xcd_barrier(bar);
        RUN(6, { phase_s5_glu(kparams(), l, opaque_s((int)blockIdx.x), opaque_s((int)gridDim.x), lds); phase_attnA(kparams(), l, opaque_s((int)blockIdx.x), opaque_s((int)gridDim.x), lds); });
        xcd_barrier(bar);
        phase_outproj(kparams(), l, opaque_s((int)blockIdx.x), opaque_s((int)gridDim.x), lds);
        xcd_barrier(bar);
        RUN(8, phase_norm2_router(kparams(), l, opaque_s((int)blockIdx.x), opaque_s((int)gridDim.x), lds));
        xcd_barrier(bar);
        RUN(10, phase_assign(kparams(), l, opaque_s((int)blockIdx.x), opaque_s((int)gridDim.x), lds));
        xcd_barrier(bar);
        RUN(11, phase_gemm1(kparams(), l, opaque_s((int)blockIdx.x), opaque_s((int)gridDim.x), lds));
        xcd_barrier(bar);
        for (int hx = 0; hx < NPASS; ++hx) {
            RUN(12, phase_gemm2(kparams(), l, hx, opaque_s((int)blockIdx.x), opaque_s((int)gridDim.x), lds));
            xcd_barrier(bar);
            phase_combine(kparams(), l, hx, opaque_s((int)blockIdx.x), opaque_s((int)gridDim.x));
            xcd_barrier(bar);
        }
    }
}
#endif

template <int PH>
static void launch_phase(Params& P, int l, int q, hipStream_t stream) {
    static bool attr_done = false;
    if (!attr_done) { (void)hipFuncSetAttribute((const void*)k_phase<PH>, hipFuncAttributeMaxDynamicSharedMemorySize, LDS_BYTES); attr_done = true; }
    P.layer = l; P.sub = q;
    hipLaunchKernelGGL(k_phase<PH>, dim3(NBLK), dim3(NTHREADS), LDS_BYTES, stream, P);
}

extern "C" void kernel_launch(void* const* d_in, const int* in_sizes, int n_in, void* d_out, int out_size, void* d_ws, size_t ws_size, hipStream_t stream) {
    Params P;
    memset(&P, 0, sizeof(P));
    for (int i = 0; i < 35; ++i) P.in[i] = (const float*)d_in[i];
    P.out = (float*)d_out; P.ws = (char*)d_ws;
    if (n_in != 35 || ws_size < WS_NEED) {
        fprintf(stderr, "kernel_launch: need %zu bytes of workspace, got %zu (n_in %d)\n", (size_t)WS_NEED, ws_size, n_in);
        launch_phase<PH_POISON>(P, 0, 0, stream);
        return;
    }
    (void)hipMemsetAsync(d_ws, 0, 16384, stream);
#if ONE_LAUNCH
    {
        static bool attr_done = false;
        if (!attr_done) { (void)hipFuncSetAttribute((const void*)k_mega, hipFuncAttributeMaxDynamicSharedMemorySize, LDS_BYTES); attr_done = true; }
        hipLaunchKernelGGL(k_mega, dim3(NBLK), dim3(NTHREADS), LDS_BYTES, stream, P);
        return;
    }
#endif
#if !ONE_LAUNCH
    launch_phase<PH_INIT>(P, 0, 0, stream);
    for (int l = 0; l < 2; ++l) {
        launch_phase<PH_PREP>(P, l, 0, stream);
        launch_phase<PH_INPROJ>(P, l, 0, stream);
        launch_phase<PH_ATTNA>(P, l, 0, stream);
        launch_phase<PH_ATTNN>(P, l, 0, stream);
        launch_phase<PH_S5SCAN>(P, l, 0, stream);
        launch_phase<PH_S5READ>(P, l, 0, stream);
        launch_phase<PH_OUTPROJ>(P, l, 0, stream);
        launch_phase<PH_NORM2>(P, l, 0, stream);
        launch_phase<PH_COUNT>(P, l, 0, stream);
        launch_phase<PH_ASSIGN>(P, l, 0, stream);
        launch_phase<PH_GEMM1>(P, l, 0, stream);
        for (int q = 0; q < 4; ++q) {
            launch_phase<PH_GEMM2>(P, l, q, stream);
            launch_phase<PH_COMBINE>(P, l, q, stream);
        }
    }
#endif
}
```
